# Optimizing an MI355X kernel written in HIP

```python
import math
import jax, jax.numpy as jnp
from jax import lax
import numpy as np

D_MODEL = 1024
BATCH = 2
SEQ = 16384
DEPTH = 2

N_MEM = 256
D_MIX = D_MODEL
HG_HEADS = 4
HG_WIDTH = D_MIX // 4
HG_DK = HG_WIDTH // HG_HEADS
HG_DV = HG_WIDTH // HG_HEADS
HG_CHUNK = 64
RG_WIDTH = D_MIX // 4
RG_BLOCKS = 4
RG_BLOCK = RG_WIDTH // RG_BLOCKS
RG_CONV = 4
RG_C = 8.0
DA_HEADS = 4
DA_WIDTH = D_MIX // 2
DA_V_DIM = DA_WIDTH // DA_HEADS
DA_QK_DIM = DA_V_DIM // 2
Q_BLOCK = 128
ROPE_THETA = 10000.0
CA_HEADS = 4
CA_HEAD_DIM = D_MODEL // CA_HEADS
D_FF = 2816
FFN_CONV = 3
LN_EPS = 1e-5
RMS_EPS = 1e-6
DEEPNORM_ALPHA = (2 * DEPTH) ** 0.25
DEEPNORM_BETA = (8 * DEPTH) ** -0.25
IN_SIZES = (HG_WIDTH, HG_WIDTH, HG_WIDTH, HG_WIDTH, HG_WIDTH,
            RG_WIDTH, RG_WIDTH,
            DA_WIDTH, DA_WIDTH, DA_WIDTH)
D_IN = sum(IN_SIZES)

kernel_name = "hybrid_hgrn2_rglru_diffattn_encoder"

F32 = jnp.float32


def _layer_norm(x, g, b):
    xf = x.astype(F32)
    mu = jnp.mean(xf, -1, keepdims=True)
    var = jnp.mean(jnp.square(xf - mu), -1, keepdims=True)
    return ((xf - mu) * lax.rsqrt(var + LN_EPS) * g.astype(F32) + b.astype(F32)).astype(x.dtype)


def _rms_norm(x, g):
    xf = x.astype(F32)
    return (xf * lax.rsqrt(jnp.mean(jnp.square(xf), -1, keepdims=True) + RMS_EPS) * g.astype(F32)).astype(x.dtype)


def _depthwise_conv(x, w, b, pad_left, pad_right):
    out = lax.conv_general_dilated(x, w[:, None, :].astype(x.dtype), window_strides=(1,),
                                   padding=[(pad_left, pad_right)],
                                   dimension_numbers=("NWC", "WIO", "NWC"),
                                   feature_group_count=x.shape[-1])
    return out + b.astype(x.dtype)


def _rotary(t, cos, sin):
    c = cos[:, :, None, None, :]
    s = sin[:, :, None, None, :]
    t1, t2 = jnp.split(t.astype(F32), 2, axis=-1)
    return jnp.concatenate([t1 * c - t2 * s, t2 * c + t1 * s], axis=-1).astype(t.dtype)


def _gated_linear_recurrence(q, k, v, logf):
    B, H, S, dk = q.shape
    dv = v.shape[-1]
    nc = S // HG_CHUNK

    def to_chunks(t):
        return jnp.moveaxis(t.reshape(B, H, nc, HG_CHUNK, t.shape[-1]), 2, 0)

    tri = jnp.tril(jnp.ones((HG_CHUNK, HG_CHUNK), dtype=bool))[:, :, None]

    def step(state, inp):
        qc, kc, vc, gc = inp
        b = jnp.cumsum(gc, axis=-2)
        o_inter = jnp.einsum("bhtd,bhde->bhte", qc * jnp.exp(b), state)
        diff = b[..., :, None, :] - b[..., None, :, :]
        decay = jnp.where(tri, jnp.exp(jnp.where(tri, diff, 0.0)), 0.0)
        att = jnp.einsum("bhtd,bhtsd,bhsd->bhts", qc, decay, kc)
        o_intra = jnp.einsum("bhts,bhse->bhte", att, vc)
        b_last = b[..., -1:, :]
        new_state = (jnp.exp(b_last)[:, :, 0, :, None] * state
                     + jnp.einsum("bhsd,bhse->bhde", kc * jnp.exp(b_last - b), vc))
        return new_state, o_inter + o_intra

    state0 = jnp.zeros((B, H, dk, dv), F32)
    _, o = lax.scan(step, state0, (to_chunks(q), to_chunks(k), to_chunks(v), to_chunks(logf)))
    return jnp.moveaxis(o, 0, 2).reshape(B, H, S, dv)


def _hgrn2_mixer(q, f_fwd, f_bwd, i, g, lb, norm_g):
    B, S, _ = q.shape

    def heads(t):
        return t.astype(F32).reshape(B, S, HG_HEADS, -1).transpose(0, 2, 1, 3)

    qh = heads(jax.nn.silu(q.astype(F32)))
    vh = heads(i)
    o = jnp.zeros((B, HG_HEADS, S, HG_DV), F32)
    for d, (fpre, rev) in enumerate(((f_fwd, False), (f_bwd, True))):
        lbd = lb[d].astype(F32)
        z = fpre.astype(F32)
        f = lbd + (1.0 - lbd) * jax.nn.sigmoid(z)
        logf = jnp.log(f)
        kh = heads((1.0 - lbd) * jax.nn.sigmoid(-z))
        gh = heads(logf)
        if rev:
            flip = lambda t: jnp.flip(t, axis=2)
            o = o + flip(_gated_linear_recurrence(flip(qh), flip(kh), flip(vh), flip(gh)))
        else:
            o = o + _gated_linear_recurrence(qh, kh, vh, gh)
    o = o.transpose(0, 2, 1, 3)
    o = _rms_norm(o, norm_g.reshape(HG_HEADS, HG_DV)).reshape(B, S, HG_WIDTH)
    return (o * jax.nn.silu(g.astype(F32))).astype(q.dtype)


def _linrec_combine(e1, e2):
    a1, b1 = e1
    a2, b2 = e2
    return a1 * a2, a2 * b1 + b2


def _rglru_mixer(xb, yb, conv_w, conv_b, wa, ba, wx, bx, lam):
    xc = _depthwise_conv(xb, conv_w, conv_b, RG_CONV // 2, RG_CONV - 1 - RG_CONV // 2).astype(F32)
    B, S, _ = xc.shape
    blocks = xc.reshape(B, S, RG_BLOCKS, RG_BLOCK)
    h = jnp.zeros_like(xc)
    for d in range(2):
        r = jax.nn.sigmoid(jnp.einsum("bsni,nij->bsnj", blocks, wa[d].astype(F32)).reshape(B, S, RG_WIDTH)
                           + ba[d].astype(F32))
        ig = jax.nn.sigmoid(jnp.einsum("bsni,nij->bsnj", blocks, wx[d].astype(F32)).reshape(B, S, RG_WIDTH)
                            + bx[d].astype(F32))
        log_a = -RG_C * r * jax.nn.softplus(-lam[d].astype(F32))
        a = jnp.exp(log_a)
        u = jnp.sqrt(-jnp.expm1(2.0 * log_a)) * (ig * xc)
        _, hd = lax.associative_scan(_linrec_combine, (a, u), reverse=(d == 1), axis=1)
        h = h + hd
    return (h * jax.nn.gelu(yb.astype(F32))).astype(xb.dtype)


def _diff_attention(q, k, v, cos, sin, lam_params, subln_g, layer):
    B, S, _ = q.shape
    q = _rotary(q.reshape(B, S, DA_HEADS, 2, DA_QK_DIM), cos, sin)
    k = _rotary(k.reshape(B, S, DA_HEADS, 2, DA_QK_DIM), cos, sin)
    v = v.reshape(B, S, DA_HEADS, DA_V_DIM)
    lam_init = 0.8 - 0.6 * math.exp(-0.3 * layer)
    lp = lam_params.astype(F32)
    lam = jnp.exp(jnp.sum(lp[0] * lp[1])) - jnp.exp(jnp.sum(lp[2] * lp[3])) + lam_init
    nb = S // Q_BLOCK
    qb = q.reshape(B, nb, Q_BLOCK, DA_HEADS, 2, DA_QK_DIM).transpose(1, 0, 3, 4, 2, 5)
    kt = k.transpose(0, 2, 3, 1, 4)
    vt = v.transpose(0, 2, 1, 3)
    scale = DA_QK_DIM ** -0.5

    def attend(qblk):
        s = jnp.einsum("bhcqd,bhckd->bhcqk", qblk, kt).astype(F32) * scale
        p = jax.nn.softmax(s, axis=-1)
        w = p[:, :, 0] - lam * p[:, :, 1]
        return jnp.einsum("bhqk,bhkv->bhqv", w.astype(vt.dtype), vt)

    o = lax.map(attend, qb)
    o = o.transpose(1, 0, 3, 2, 4).reshape(B, S, DA_HEADS, DA_V_DIM)
    o = _rms_norm(o, subln_g) * (1.0 - lam_init)
    return o.reshape(B, S, DA_WIDTH).astype(q.dtype)


def _memory_cross_attention(x, mem, wq, wk, wv, wo):
    B, S, _ = x.shape
    M = mem.shape[1]
    q = (x @ wq).reshape(B, S, CA_HEADS, CA_HEAD_DIM)
    k = (mem @ wk).reshape(B, M, CA_HEADS, CA_HEAD_DIM)
    v = (mem @ wv).reshape(B, M, CA_HEADS, CA_HEAD_DIM)
    s = jnp.einsum("bshd,bmhd->bhsm", q, k).astype(F32) * (CA_HEAD_DIM ** -0.5)
    p = jax.nn.softmax(s, axis=-1)
    o = jnp.einsum("bhsm,bmhd->bshd", p.astype(v.dtype), v).reshape(B, S, D_MODEL)
    return o @ wo


def _conv_glu_ffn(x, w_up, conv_w, conv_b, w_down):
    gate, val = jnp.split(x @ w_up, 2, axis=-1)
    gate = _depthwise_conv(gate, conv_w, conv_b, FFN_CONV // 2, FFN_CONV // 2)
    return (jax.nn.gelu(gate) * val) @ w_down


def setup_inputs(seed: int = 0) -> dict:
    key = jax.random.key(seed)
    ks = iter(jax.random.split(key, 40))
    L = DEPTH
    nrm = lambda shape, scale: jax.random.normal(next(ks), shape, F32) * scale
    gain = lambda shape: 1.0 + 0.02 * jax.random.normal(next(ks), shape, F32)
    small = lambda shape: 0.01 * jax.random.normal(next(ks), shape, F32)

    x = jax.random.normal(next(ks), (BATCH, SEQ, D_MODEL), F32)
    mem = jax.random.normal(next(ks), (BATCH, N_MEM, D_MODEL), F32)
    positions = jnp.broadcast_to(jnp.arange(SEQ, dtype=jnp.int32), (BATCH, SEQ))

    col_scale = jnp.concatenate([jnp.ones((D_IN - DA_WIDTH,), F32), jnp.full((DA_WIDTH,), DEEPNORM_BETA, F32)])
    w_in = nrm((L, D_MODEL, D_IN), D_MODEL ** -0.5) * col_scale

    hg_lower_bounds = nrm((L, 2, HG_WIDTH), 0.1)
    hg_norm_g = gain((L, HG_WIDTH))

    rg_conv_w = nrm((L, RG_CONV, RG_WIDTH), RG_CONV ** -0.5)
    rg_conv_b = small((L, RG_WIDTH))
    rg_wa = nrm((L, 2, RG_BLOCKS, RG_BLOCK, RG_BLOCK), RG_BLOCK ** -0.5)
    rg_ba = small((L, 2, RG_WIDTH))
    rg_wx = nrm((L, 2, RG_BLOCKS, RG_BLOCK, RG_BLOCK), RG_BLOCK ** -0.5)
    rg_bx = small((L, 2, RG_WIDTH))
    u = jax.random.uniform(next(ks), (L, 2, RG_WIDTH), F32, minval=0.9, maxval=0.999)
    a0 = u ** (1.0 / RG_C)
    rg_lambda = jnp.log(a0) - jnp.log1p(-a0)

    da_lambda = nrm((L, 4, DA_QK_DIM), 0.1)
    da_subln_g = gain((L, DA_V_DIM))

    w_out = nrm((L, D_MIX, D_MODEL), D_MIX ** -0.5 * DEEPNORM_BETA)
    ln1_g = gain((L, D_MODEL)); ln1_b = small((L, D_MODEL))

    ca_wq = nrm((L, D_MODEL, D_MODEL), D_MODEL ** -0.5)
    ca_wk = nrm((L, D_MODEL, D_MODEL), D_MODEL ** -0.5)
    ca_wv = nrm((L, D_MODEL, D_MODEL), D_MODEL ** -0.5 * DEEPNORM_BETA)
    ca_wo = nrm((L, D_MODEL, D_MODEL), D_MODEL ** -0.5 * DEEPNORM_BETA)
    ln2_g = gain((L, D_MODEL)); ln2_b = small((L, D_MODEL))

    ffn_w_up = nrm((L, D_MODEL, 2 * D_FF), D_MODEL ** -0.5 * DEEPNORM_BETA)
    ffn_conv_w = nrm((L, FFN_CONV, D_FF), FFN_CONV ** -0.5)
    ffn_conv_b = small((L, D_FF))
    ffn_w_down = nrm((L, D_FF, D_MODEL), D_FF ** -0.5 * DEEPNORM_BETA)
    ln3_g = gain((L, D_MODEL)); ln3_b = small((L, D_MODEL))

    return {"x": x, "mem": mem, "positions": positions, "w_in": w_in,
            "hg_lower_bounds": hg_lower_bounds, "hg_norm_g": hg_norm_g,
            "rg_conv_w": rg_conv_w, "rg_conv_b": rg_conv_b, "rg_wa": rg_wa, "rg_ba": rg_ba,
            "rg_wx": rg_wx, "rg_bx": rg_bx, "rg_lambda": rg_lambda,
            "da_lambda": da_lambda, "da_subln_g": da_subln_g,
            "w_out": w_out, "ln1_g": ln1_g, "ln1_b": ln1_b,
            "ca_wq": ca_wq, "ca_wk": ca_wk, "ca_wv": ca_wv, "ca_wo": ca_wo,
            "ln2_g": ln2_g, "ln2_b": ln2_b,
            "ffn_w_up": ffn_w_up, "ffn_conv_w": ffn_conv_w, "ffn_conv_b": ffn_conv_b,
            "ffn_w_down": ffn_w_down, "ln3_g": ln3_g, "ln3_b": ln3_b}


def reference(x, mem, positions, w_in, hg_lower_bounds, hg_norm_g, rg_conv_w, rg_conv_b, rg_wa, rg_ba,
              rg_wx, rg_bx, rg_lambda, da_lambda, da_subln_g, w_out, ln1_g, ln1_b,
              ca_wq, ca_wk, ca_wv, ca_wo, ln2_g, ln2_b, ffn_w_up, ffn_conv_w, ffn_conv_b,
              ffn_w_down, ln3_g, ln3_b):
    inv_freq = 1.0 / (ROPE_THETA ** (jnp.arange(0, DA_QK_DIM, 2, dtype=F32) / DA_QK_DIM))
    ang = positions.astype(F32)[..., None] * inv_freq
    cos, sin = jnp.cos(ang), jnp.sin(ang)

    lb_soft = jax.nn.softmax(hg_lower_bounds.astype(F32), axis=0)
    lb_all = jnp.cumsum(lb_soft, axis=0) - lb_soft[0:1]

    split_idx = [int(v) for v in np.cumsum(IN_SIZES)[:-1]]

    for layer in range(DEPTH):
        proj = x @ w_in[layer]
        hq, hf_f, hf_b, hi, hg, rx, ry, dq, dk, dv = jnp.split(proj, split_idx, axis=-1)
        o_hg = _hgrn2_mixer(hq, hf_f, hf_b, hi, hg, lb_all[layer], hg_norm_g[layer])
        o_rg = _rglru_mixer(rx, ry, rg_conv_w[layer], rg_conv_b[layer], rg_wa[layer], rg_ba[layer],
                            rg_wx[layer], rg_bx[layer], rg_lambda[layer])
        o_da = _diff_attention(dq, dk, dv, cos, sin, da_lambda[layer], da_subln_g[layer], layer)
        mix = jnp.concatenate([o_hg.astype(x.dtype), o_rg.astype(x.dtype), o_da.astype(x.dtype)], axis=-1) @ w_out[layer]
        x = _layer_norm(DEEPNORM_ALPHA * x + mix, ln1_g[layer], ln1_b[layer])
        ca = _memory_cross_attention(x, mem, ca_wq[layer], ca_wk[layer], ca_wv[layer], ca_wo[layer])
        x = _layer_norm(DEEPNORM_ALPHA * x + ca, ln2_g[layer], ln2_b[layer])
        ff = _conv_glu_ffn(x, ffn_w_up[layer], ffn_conv_w[layer], ffn_conv_b[layer], ffn_w_down[layer])
        x = _layer_norm(DEEPNORM_ALPHA * x + ff, ln3_g[layer], ln3_b[layer])
    return x
```

```cpp
#include <hip/hip_runtime.h>
#include <hip/hip_cooperative_groups.h>
#include <cstdio>
#include <cstdint>
namespace cg = cooperative_groups;

#define LAS __attribute__((address_space(3)))
typedef unsigned short bf16_t;
typedef short bf16x8 __attribute__((ext_vector_type(8)));
typedef short s16x4 __attribute__((ext_vector_type(4)));
typedef float f32x4 __attribute__((ext_vector_type(4)));
typedef float f32x16 __attribute__((ext_vector_type(16)));
typedef unsigned u32x4 __attribute__((ext_vector_type(4)));
typedef unsigned u32x2 __attribute__((ext_vector_type(2)));

constexpr int BATCH = 2, SEQ = 16384, DM = 1024, DEPTH = 2, M = BATCH * SEQ, DIN = 3328, DFF = 2816, NMEM = 256;
constexpr float ALPHA = 1.4142135623730951f;
constexpr size_t MiB = 1u << 20;
constexpr size_t WS_COS = 0, WS_SIN = 4 * MiB, WS_SMALL = 8 * MiB;
constexpr size_t WS_RGW = 8 * MiB + 131072;
constexpr size_t WS_STATS = 8 * MiB + 524288;
constexpr size_t WS_GB = 9 * MiB;
constexpr size_t WS_BT2 = 17 * MiB;
constexpr size_t WS_W = 25 * MiB;
constexpr size_t W_IN = 0, W_OUT = 13 * MiB / 2, W_Q = W_OUT + 2 * MiB, W_K = W_Q + 2 * MiB, W_V = W_K + 2 * MiB, W_O = W_V + 2 * MiB, W_UP = W_O + 2 * MiB, W_DN = W_UP + 11 * MiB, W_LAYER = W_DN + 11 * MiB / 2;
static_assert(W_LAYER == 33 * MiB && WS_W + 2 * W_LAYER <= 92 * MiB, "weights per layer");
constexpr size_t WS_ARENA = 92 * MiB;
constexpr size_t A_XN = WS_ARENA;
constexpr size_t A_HQ = WS_ARENA + 64 * MiB, A_HI = A_HQ + 16 * MiB, A_HG = A_HI + 16 * MiB, A_RY = A_HG + 16 * MiB;
constexpr size_t A_ZF0 = A_RY + 16 * MiB, A_ZF1 = A_ZF0 + 32 * MiB, A_RX = A_ZF1 + 32 * MiB;
constexpr size_t A_DQ = A_RX + 32 * MiB, A_DK = A_DQ + 32 * MiB, A_DV = A_DK + 32 * MiB;
constexpr size_t A_ST = A_DV + 32 * MiB;
constexpr size_t A_RGAGG = A_ST + 64 * MiB, A_RGCAR = A_RGAGG + 1 * MiB, A_HD = A_RGCAR + 1 * MiB, A_MIX_END = A_HD + 1 * MiB;
constexpr size_t A_P = WS_ARENA + 64 * MiB, A_LSUM = A_P + 64 * MiB;
constexpr size_t A_MEMB = A_LSUM + 4 * MiB, A_KMEM = A_MEMB + 1 * MiB, A_VMEM = A_KMEM + 2 * MiB;
constexpr size_t A_GATE = WS_ARENA + 64 * MiB, A_VAL = A_GATE + 176 * MiB, WS_END = A_VAL + 176 * MiB;
static_assert(WS_END <= 512 * MiB && A_MIX_END + 32 * MiB <= 512 * MiB, "workspace map");

constexpr int LDS_BYTES = 132096;
#ifndef PHMASK
#define PHMASK 0xFFFFFFFFu
#endif
#define PH(k) ((PHMASK >> (k)) & 1u)
#ifndef REPMASK
#define REPMASK 0u
#endif
#define REPS(k) ({ int r_ = 1 + (int)((REPMASK >> (k)) & 1u); asm volatile("" : "+s"(r_)); r_; })

struct Params { const void* in[30]; float* out; unsigned char* ws; };

__device__ __forceinline__ int ltid() { int t = threadIdx.x; asm volatile("" : "+v"(t)); return t; }
__device__ __forceinline__ int lbid() { int t = blockIdx.x; asm volatile("" : "+s"(t)); return t; }
__device__ __forceinline__ int lgdim() { int t = gridDim.x; asm volatile("" : "+s"(t)); return t; }
typedef float f32x2_cv __attribute__((ext_vector_type(2))); typedef __bf16 bf16x2_cv __attribute__((ext_vector_type(2)));
__device__ __forceinline__ unsigned pk2(float lo, float hi) { const f32x2_cv v = {lo, hi}; return __builtin_bit_cast(unsigned, __builtin_convertvector(v, bf16x2_cv)); }
__device__ __forceinline__ unsigned f2bf(float f) { return pk2(f, 0.f) & 0xffffu; }
__device__ __forceinline__ float bf2f(unsigned h) { return __builtin_bit_cast(float, h << 16); }
__device__ __forceinline__ float bflo(unsigned w) { return __builtin_bit_cast(float, w << 16); }
__device__ __forceinline__ float bfhi(unsigned w) { return __builtin_bit_cast(float, w & 0xffff0000u); }
__device__ __forceinline__ unsigned cvt_pk_bf16(float lo, float hi) { unsigned r; asm volatile("v_cvt_pk_bf16_f32 %0, %1, %2" : "=v"(r) : "v"(lo), "v"(hi)); return r; }
template <int CTRL> __device__ __forceinline__ float dppf(float v) { return __builtin_bit_cast(float, __builtin_amdgcn_update_dpp(0, __builtin_bit_cast(int, v), CTRL, 0xF, 0xF, true)); }
__device__ __forceinline__ float swap16_sum(float v) { auto r = __builtin_amdgcn_permlane16_swap(__float_as_uint(v), __float_as_uint(v), false, false); return __uint_as_float(r[0]) + __uint_as_float(r[1]); }
__device__ __forceinline__ float swap32_sum(float v) { auto r = __builtin_amdgcn_permlane32_swap(__float_as_uint(v), __float_as_uint(v), false, false); return __uint_as_float(r[0]) + __uint_as_float(r[1]); }
__device__ __forceinline__ float sum8(float v) { v += dppf<0xB1>(v); v += dppf<0x4E>(v); v += dppf<0x141>(v); return v; }
__device__ __forceinline__ float sum16(float v) { v = sum8(v); v += dppf<0x140>(v); return v; }
__device__ __forceinline__ float sum32(float v) { return swap16_sum(sum16(v)); }
__device__ __forceinline__ float sum64(float v) { return swap32_sum(sum32(v)); }
__device__ __forceinline__ float sigm(float x) { return __builtin_amdgcn_rcpf(1.f + __expf(-x)); }
__device__ __forceinline__ float siluf(float x) { return x * sigm(x); }
__device__ __forceinline__ float nexpm1(float x) { const float p = -x * (1.f + x * (0.5f + x * (0.16666667f + x * (0.041666668f + x * (0.0083333338f + x * 0.0013888889f))))); return x > -0.5f ? p : 1.f - __expf(x); }
__device__ __forceinline__ float gelu_tanh(float x) { const float t = x * (-2.3022082f + -0.10294324f * (x * x)); return x * __builtin_amdgcn_rcpf(1.f + __builtin_amdgcn_exp2f(t)); }
__device__ __forceinline__ u32x4 pack8(const float* v) { u32x4 w; w.x = cvt_pk_bf16(v[0], v[1]); w.y = cvt_pk_bf16(v[2], v[3]); w.z = cvt_pk_bf16(v[4], v[5]); w.w = cvt_pk_bf16(v[6], v[7]); return w; }
__device__ __forceinline__ void unpack8(u32x4 w, float* v) { v[0] = bflo(w.x); v[1] = bfhi(w.x); v[2] = bflo(w.y); v[3] = bfhi(w.y); v[4] = bflo(w.z); v[5] = bfhi(w.z); v[6] = bflo(w.w); v[7] = bfhi(w.w); }

namespace pg8 {
constexpr int BM = 256, BK = 64, HALF = 128, HTB = HALF * BK * 2, STAGE_BYTES = 8 * HTB, NXCD = 8, WGM = 8;
__host__ __device__ __forceinline__ int lds_byte(int r, int c) { const int st = (r >> 4) * 2 + (c >> 5), rr = r & 15, cc = c & 31, ob = rr * 64 + cc * 2; return st * 1024 + (ob ^ (((ob >> 9) & 1) << 5)); }
__host__ __device__ __forceinline__ void stage_rc(int b, int& R, int& C) { const int st = b / 1024, sb = b % 1024, swz = sb ^ (((sb >> 9) & 1) << 5); R = (st >> 1) * 16 + swz / 64; C = (st & 1) * 32 + (swz % 64) / 2; }
__host__ __device__ __forceinline__ int perm32(int rho) { const int n = rho >> 4, i = rho & 15; return 8 * (i >> 2) + 4 * n + (i & 3); }
struct Unit { int pm, pn; };
struct Gemm { const bf16_t* A; const bf16_t* Bt; int M, N, K, lda, ldb; int pm_per_batch; size_t b_batch_stride; };
struct StaticOrder {
    int nM, nN, nwg, G, c;
    __device__ void init(int M_, int N_, int G_, int c_) { nM = M_ / BM; nN = N_ / BM; nwg = nM * nN; G = G_; c = c_; }
    __device__ bool next(int i, Unit& u) const {
        const long L = (long)i * G + c; if (L >= nwg) return false;
        int wgid = (int)L; { const int q = nwg / NXCD, r = nwg % NXCD, xcd = wgid % NXCD, off = wgid / NXCD; wgid = (xcd < r ? xcd * (q + 1) : r * (q + 1) + (xcd - r) * q) + off; }
        const int nig = WGM * nN, gid = wgid / nig, fm = gid * WGM, gsz = (nM - fm) < WGM ? (nM - fm) : WGM;
        u.pm = fm + ((wgid % nig) % gsz); u.pn = (wgid % nig) / gsz; return true;
    }
};
template <class F> struct EpiRow8 {
    F f;
    __device__ __forceinline__ void operator()(const f32x4 (&acc)[2][2][4][2], const Unit& u, int wr, int wc, int fr, int fq) const {
        const int row0 = u.pm * BM + wr * 64 + fr, colb = u.pn * BM + wc * 32 + 8 * fq;
#pragma unroll
        for (int ai = 0; ai < 2; ++ai)
#pragma unroll
            for (int m = 0; m < 4; ++m)
            {
#pragma unroll
              for (int bj = 0; bj < 2; ++bj) f(row0 + ai * HALF + m * 16, colb + bj * HALF, acc[ai][bj][m][0], acc[ai][bj][m][1]);
              asm volatile("" ::: "memory"); }
    }
};

template <class Epi, bool APERM = false>
__device__ __forceinline__ void gemm_phase(LAS unsigned char* lds, const Gemm g, const StaticOrder& S, const Epi& E) {
    int tid_ = threadIdx.x; asm volatile("" : "+v"(tid_));
    const int tid = tid_, wid = __builtin_amdgcn_readfirstlane(tid >> 6), lane = tid & 63, wr = wid >> 2, wc = wid & 3, fr = lane & 15, fq = lane >> 4;
    const int K = g.K, nt = K / BK;
    unsigned voffA[2], voffB[2];
#pragma unroll
    for (int i = 0; i < 2; ++i) { int R, C; stage_rc(tid * 16 + i * 8192, R, C); const int Rb = (R & ~31) + perm32(R & 31);
        const int Ra = APERM ? (128 * (R >> 6) + 8 * (R & 15) + ((R >> 4) & 3)) : R;
        voffA[i] = (unsigned)(Ra * g.lda + C) * 2u; voffB[i] = (unsigned)(Rb * g.ldb + C) * 2u; }
    const size_t kstep = (size_t)(BK * 2);
    const size_t hstepA = (size_t)(APERM ? 4 : HALF) * g.lda * 2, hstepB = (size_t)HALF * g.ldb * 2;
    const size_t tstepA = (size_t)BM * g.lda * 2, tstepB = 2 * hstepB;
    const unsigned ldsw = (unsigned)wid * 1024u;
    const int aoff = lds_byte(wr * 64 + fr, fq * 8), boff = lds_byte(wc * 32 + fr, fq * 8);
#define PG8_SA(b, h) (((b) * 2 + (h)) * HTB)
#define PG8_SB(b, h) ((4 + (b) * 2 + (h)) * HTB)
#define PG8_STAGE(bufoff, gbase, voff) do { _Pragma("unroll") for (int _i = 0; _i < 2; ++_i) \
        __builtin_amdgcn_global_load_lds((const unsigned*)((const char*)(gbase) + (voff)[_i]), (LAS unsigned*)(lds + (bufoff) + ldsw + _i * 8192), 16, 0, 0); } while (0)
#define PG8_LDA(dst, b, h) do { _Pragma("unroll") for (int m = 0; m < 4; ++m) _Pragma("unroll") for (int k = 0; k < 2; ++k) dst[m][k] = *(const LAS bf16x8*)(lds + PG8_SA(b, h) + aoff + m * 2048 + k * 1024); } while (0)
#define PG8_LDB(dst, b, h) do { _Pragma("unroll") for (int n = 0; n < 2; ++n) _Pragma("unroll") for (int k = 0; k < 2; ++k) dst[n][k] = *(const LAS bf16x8*)(lds + PG8_SB(b, h) + boff + n * 2048 + k * 1024); } while (0)
#define PG8_MMA(ai, bj, At, Bt) do { __builtin_amdgcn_s_setprio(1); _Pragma("unroll") for (int m = 0; m < 4; ++m) _Pragma("unroll") for (int n = 0; n < 2; ++n) _Pragma("unroll") for (int k = 0; k < 2; ++k) \
        acc[ai][bj][m][n] = __builtin_amdgcn_mfma_f32_16x16x32_bf16(Bt[n][k], At[m][k], acc[ai][bj][m][n], 0, 0, 0); __builtin_amdgcn_s_setprio(0); } while (0)
#define PG8_WAIT_V(n) asm volatile("s_waitcnt vmcnt(" #n ")" ::: "memory")
#define PG8_WAIT_L(n) asm volatile("s_waitcnt lgkmcnt(" #n ")" ::: "memory")
#define PG8_BAR __builtin_amdgcn_s_barrier()
#define PG8_SCHED __builtin_amdgcn_sched_barrier(0)
    Unit cur, nxt; int ui = 0;
    if (!S.next(0, cur)) return;
    f32x4 acc[2][2][4][2];
#pragma unroll
    for (int a = 0; a < 2; ++a)
#pragma unroll
        for (int b = 0; b < 2; ++b)
#pragma unroll
            for (int m = 0; m < 4; ++m)
#pragma unroll
                for (int n = 0; n < 2; ++n) acc[a][b][m][n] = (f32x4){0.f, 0.f, 0.f, 0.f};
    bf16x8 At[4][2], B0[2][2], B1[2][2];
    const char* cA = (const char*)g.A + (size_t)cur.pm * tstepA;
    const char* cB = (const char*)g.Bt + (size_t)cur.pn * tstepB + (size_t)(cur.pm / g.pm_per_batch) * g.b_batch_stride * 2;
    PG8_WAIT_V(0);
    PG8_STAGE(PG8_SB(0, 0), cB, voffB); PG8_STAGE(PG8_SB(0, 1), cB + hstepB, voffB); PG8_STAGE(PG8_SA(0, 0), cA, voffA); PG8_STAGE(PG8_SA(0, 1), cA + hstepA, voffA);
    if (wr == 1) PG8_BAR;
    PG8_WAIT_V(2); PG8_BAR;
    PG8_STAGE(PG8_SB(1, 0), cB + kstep, voffB); PG8_STAGE(PG8_SA(1, 0), cA + kstep, voffA); PG8_STAGE(PG8_SB(1, 1), cB + hstepB + kstep, voffB);
    PG8_WAIT_V(6); PG8_BAR;
    for (;;) {
        const bool has_next = S.next(ui + 1, nxt);
        const char* nA = has_next ? (const char*)g.A + (size_t)nxt.pm * tstepA : cA;
        const char* nB = has_next ? (const char*)g.Bt + (size_t)nxt.pn * tstepB + (size_t)(nxt.pm / g.pm_per_batch) * g.b_batch_stride * 2 : cB;
        for (int t = 0; t < nt; t += 2) {
            const bool last = (t == nt - 2);
            const char* a1 = cA + (size_t)(t + 1) * kstep;
            const char* a2 = last ? nA : cA + (size_t)(t + 2) * kstep; const char* b2 = last ? nB : cB + (size_t)(t + 2) * kstep;
            const char* a3 = a2 + kstep; const char* b3 = b2 + kstep;
            PG8_LDB(B0, 0, 0); PG8_LDB(B1, 0, 1); PG8_SCHED; PG8_LDA(At, 0, 0); PG8_STAGE(PG8_SA(1, 1), a1 + hstepA, voffA);
            PG8_WAIT_V(8); PG8_WAIT_L(0); PG8_BAR; PG8_MMA(0, 0, At, B0); PG8_MMA(0, 1, At, B1); PG8_BAR; PG8_SCHED;
            PG8_LDA(At, 0, 1); PG8_STAGE(PG8_SB(0, 0), b2, voffB); PG8_STAGE(PG8_SB(0, 1), b2 + hstepB, voffB); PG8_STAGE(PG8_SA(0, 0), a2, voffA);
            PG8_WAIT_V(8); PG8_WAIT_L(0); PG8_BAR; PG8_MMA(1, 0, At, B0); PG8_MMA(1, 1, At, B1); PG8_BAR; PG8_SCHED;
            PG8_LDB(B0, 1, 0); PG8_LDB(B1, 1, 1); PG8_SCHED; PG8_LDA(At, 1, 0); PG8_STAGE(PG8_SA(0, 1), a2 + hstepA, voffA);
            PG8_WAIT_V(8); PG8_WAIT_L(0); PG8_BAR; PG8_MMA(0, 0, At, B0); PG8_MMA(0, 1, At, B1); PG8_BAR; PG8_SCHED;
            PG8_LDA(At, 1, 1); PG8_STAGE(PG8_SB(1, 0), b3, voffB); PG8_STAGE(PG8_SB(1, 1), b3 + hstepB, voffB); PG8_STAGE(PG8_SA(1, 0), a3, voffA);
            PG8_WAIT_V(8); PG8_WAIT_L(0); PG8_BAR; PG8_MMA(1, 0, At, B0); PG8_MMA(1, 1, At, B1); PG8_BAR; PG8_SCHED;
        }
        if (wr == 0) PG8_BAR;
        E(acc, cur, wr, wc, fr, fq);
        if (!has_next) break;
#pragma unroll
        for (int a = 0; a < 2; ++a)
#pragma unroll
            for (int b = 0; b < 2; ++b)
#pragma unroll
                for (int m = 0; m < 4; ++m)
#pragma unroll
                    for (int n = 0; n < 2; ++n) acc[a][b][m][n] = (f32x4){0.f, 0.f, 0.f, 0.f};
        cur = nxt; cA = nA; cB = nB; ++ui;
        if (wr == 1) PG8_BAR;
    }
    PG8_WAIT_V(0);
    PG8_BAR;
#undef PG8_SA
#undef PG8_SB
#undef PG8_STAGE
#undef PG8_LDA
#undef PG8_LDB
#undef PG8_MMA
#undef PG8_WAIT_V
#undef PG8_WAIT_L
#undef PG8_BAR
#undef PG8_SCHED
}
}

__device__ __forceinline__ void st8_bf16(bf16_t* p, const float* v) { *(u32x4*)p = pack8(v); }
__device__ __forceinline__ void st8_f32(float* p, const float* v) { *(f32x4*)p = (f32x4){v[0], v[1], v[2], v[3]}; *(f32x4*)(p + 4) = (f32x4){v[4], v[5], v[6], v[7]}; }

struct FProj {
    bf16_t *HQ, *HI, *HG, *RY, *DQ, *DK, *DV; float *ZF0, *ZF1, *RX; const float *cs, *sn;
    __device__ __forceinline__ void operator()(int row, int col, f32x4 v0, f32x4 v1) const {
        float v[8] = {v0[0], v0[1], v0[2], v0[3], v1[0], v1[1], v1[2], v1[3]};
        const int seg = col >> 8, c = col & 255;
        if (seg == 0) {
#pragma unroll
            for (int i = 0; i < 8; ++i) v[i] = siluf(v[i]);
            st8_bf16(HQ + (size_t)row * 256 + c, v);
        } else if (seg == 1) { st8_f32(ZF0 + (size_t)row * 256 + c, v);
        } else if (seg == 2) { st8_f32(ZF1 + (size_t)row * 256 + c, v);
        } else if (seg == 3) { st8_bf16(HI + (size_t)row * 256 + c, v);
        } else if (seg == 4) {
#pragma unroll
            for (int i = 0; i < 8; ++i) v[i] = siluf(v[i]);
            st8_bf16(HG + (size_t)row * 256 + c, v);
        } else if (seg == 5) { st8_f32(RX + (size_t)row * 256 + c, v);
        } else if (seg == 6) {
#pragma unroll
            for (int i = 0; i < 8; ++i) v[i] = gelu_tanh(v[i]);
            st8_bf16(RY + (size_t)row * 256 + c, v);
        } else if (seg <= 10) {
            const int cc = col - (seg <= 8 ? 1792 : 2304); const int i0 = (cc & 63) >> 1;
            const f32x4 cv = *(const f32x4*)(cs + (size_t)row * 32 + i0), sv = *(const f32x4*)(sn + (size_t)row * 32 + i0);
            float o[8];
#pragma unroll
            for (int k = 0; k < 4; ++k) { const float t1 = v[2 * k], t2 = v[2 * k + 1]; o[2 * k] = t1 * cv[k] - t2 * sv[k]; o[2 * k + 1] = t2 * cv[k] + t1 * sv[k]; }
            if (seg <= 8) {
#pragma unroll
                for (int k = 0; k < 8; ++k) o[k] *= 0.18033688011112042f;
            }
            st8_bf16((seg <= 8 ? DQ : DK) + (size_t)row * 512 + cc, o);
        } else { st8_bf16(DV + (size_t)row * 512 + (col - 2816), v); }
    }
};
struct FRes {
    const float* res; float* out; const float* st; const float* g; const float* b;
    __device__ __forceinline__ void operator()(int row, int col, f32x4 v0, f32x4 v1) const {
        const size_t o = (size_t)row * DM + col; f32x4 r0 = *(const f32x4*)(res + o), r1 = *(const f32x4*)(res + o + 4);
        if (st) { typedef float f32x2 __attribute__((ext_vector_type(2))); const f32x2 ms = *(const f32x2*)(st + (size_t)row * 2);
            r0 = (r0 - ms[0]) * ms[1] * *(const f32x4*)(g + col) + *(const f32x4*)(b + col); r1 = (r1 - ms[0]) * ms[1] * *(const f32x4*)(g + col + 4) + *(const f32x4*)(b + col + 4); }
        *(f32x4*)(out + o) = r0 * ALPHA + v0; *(f32x4*)(out + o + 4) = r1 * ALPHA + v1;
    }
};
struct EpiRes {
    const float* res; float* out; const float* st; const float* g; const float* b;
    __device__ __forceinline__ void operator()(const f32x4 (&acc)[2][2][4][2], const pg8::Unit& u, int wr, int wc, int fr, int fq) const {
        typedef float f32x2 __attribute__((ext_vector_type(2)));
        const int row0 = u.pm * 256 + wr * 64 + fr, colb = u.pn * 256 + wc * 32 + 8 * fq;
#pragma unroll
        for (int ai = 0; ai < 2; ++ai)
#pragma unroll
        for (int mh = 0; mh < 2; ++mh) {
            f32x4 r[2][2][2]; f32x2 ms[2];
#pragma unroll
            for (int mm = 0; mm < 2; ++mm) { const int m = mh * 2 + mm; const size_t o = (size_t)(row0 + ai * 128 + m * 16) * DM + colb;
                r[mm][0][0] = *(const f32x4*)(res + o); r[mm][0][1] = *(const f32x4*)(res + o + 4); r[mm][1][0] = *(const f32x4*)(res + o + 128); r[mm][1][1] = *(const f32x4*)(res + o + 132);
                ms[mm] = st ? *(const f32x2*)(st + (size_t)(row0 + ai * 128 + m * 16) * 2) : (f32x2){0.f, 1.f}; }
#pragma unroll
            for (int bj = 0; bj < 2; ++bj) {
                f32x4 g0 = {1.f, 1.f, 1.f, 1.f}, g1 = g0, b0 = {0.f, 0.f, 0.f, 0.f}, b1 = b0;
                if (st) { g0 = *(const f32x4*)(g + colb + bj * 128); g1 = *(const f32x4*)(g + colb + bj * 128 + 4); b0 = *(const f32x4*)(b + colb + bj * 128); b1 = *(const f32x4*)(b + colb + bj * 128 + 4); }
#pragma unroll
                for (int mm = 0; mm < 2; ++mm) { const int m = mh * 2 + mm; const size_t o = (size_t)(row0 + ai * 128 + m * 16) * DM + colb + bj * 128;
                    f32x4 x0 = r[mm][bj][0], x1 = r[mm][bj][1];
                    if (st) { x0 = (x0 - ms[mm][0]) * ms[mm][1] * g0 + b0; x1 = (x1 - ms[mm][0]) * ms[mm][1] * g1 + b1; }
                    *(f32x4*)(out + o) = x0 * ALPHA + acc[ai][bj][m][0]; *(f32x4*)(out + o + 4) = x1 * ALPHA + acc[ai][bj][m][1]; }
            }
            asm volatile("" ::: "memory");
        }
    }
};
struct FScores {
    bf16_t* P; float* LS;
    __device__ __forceinline__ void operator()(int row, int col, f32x4 v0, f32x4 v1) const {
        float e[8];
#pragma unroll
        for (int i = 0; i < 4; ++i) { e[i] = __expf(v0[i] * 0.0625f - 10.f); e[4 + i] = __expf(v1[i] * 0.0625f - 10.f); }
        const u32x4 w = pack8(e); *(u32x4*)(P + (size_t)row * DM + col) = w;
        float s = (bflo(w.x) + bfhi(w.x)) + (bflo(w.y) + bfhi(w.y)) + (bflo(w.z) + bfhi(w.z)) + (bflo(w.w) + bfhi(w.w));
        s = swap32_sum(swap16_sum(s));
        if ((ltid() & 63) < 16) LS[(size_t)row * 32 + (col >> 8) * 8 + ((col & 255) >> 5)] = s;
    }
};
struct FStore {
    bf16_t* O; int ldc;
    __device__ __forceinline__ void operator()(int row, int col, f32x4 v0, f32x4 v1) const {
        const float v[8] = {v0[0], v0[1], v0[2], v0[3], v1[0], v1[1], v1[2], v1[3]}; st8_bf16(O + (size_t)row * ldc + col, v);
    }
};
struct FUp {
    bf16_t *G, *V;
    __device__ __forceinline__ void operator()(int row, int col, f32x4 v0, f32x4 v1) const {
        const float v[8] = {v0[0], v0[1], v0[2], v0[3], v1[0], v1[1], v1[2], v1[3]};
        if (col < DFF) st8_bf16(G + (size_t)row * DFF + col, v); else st8_bf16(V + (size_t)row * DFF + (col - DFF), v);
    }
};


struct EpiUpConv {
    bf16_t* H; float* SB; const float* cw; const float* cb;
    __device__ __forceinline__ void operator()(const f32x4 (&acc)[2][2][4][2], const pg8::Unit& u, int wr, int wc, int fr, int fq) const {
        const int T0 = u.pm * 256 + wr * 128 + fr * 8, grp = u.pm * 2 + wr;
#pragma unroll
        for (int n = 0; n < 2; ++n) {
            const int c = u.pn * 128 + wc * 32 + fq * 8 + n * 4;
            const f32x4 w0 = *(const f32x4*)(cw + c), w1 = *(const f32x4*)(cw + DFF + c), w2 = *(const f32x4*)(cw + 2 * DFF + c), bb = *(const f32x4*)(cb + c);
            f32x4 gp, gn;
#pragma unroll
            for (int e = 0; e < 4; ++e) { gp[e] = dppf<0x111>(acc[1][0][3][n][e]); gn[e] = dppf<0x101>(acc[0][0][0][n][e]); }
#pragma unroll
            for (int k = 0; k < 8; ++k) {
                const f32x4 gc = acc[k >> 2][0][k & 3][n];
                const f32x4 gl = (k == 0) ? gp : acc[(k - 1) >> 2][0][(k - 1) & 3][n];
                const f32x4 gr = (k == 7) ? gn : acc[(k + 1) >> 2][0][(k + 1) & 3][n];
                const f32x4 vv = acc[k >> 2][1][k & 3][n];
                const bool edgeF = (k == 0) && (fr == 0), edgeL = (k == 7) && (fr == 15);
                if (edgeF) { const size_t o = (size_t)grp * DFF + c; *(f32x4*)(SB + 0 * 256 * (size_t)DFF + o) = w1 * gc + w2 * gr + bb; *(f32x4*)(SB + 1 * 256 * (size_t)DFF + o) = vv; *(f32x4*)(SB + 2 * 256 * (size_t)DFF + o) = gc; }
                else if (edgeL) { const size_t o = (size_t)grp * DFF + c; *(f32x4*)(SB + 3 * 256 * (size_t)DFF + o) = w0 * gl + w1 * gc + bb; *(f32x4*)(SB + 4 * 256 * (size_t)DFF + o) = vv; *(f32x4*)(SB + 5 * 256 * (size_t)DFF + o) = gc; }
                else { const f32x4 a = w0 * gl + w1 * gc + w2 * gr + bb;
                    u32x2 w; w.x = cvt_pk_bf16(gelu_tanh(a[0]) * vv[0], gelu_tanh(a[1]) * vv[1]); w.y = cvt_pk_bf16(gelu_tanh(a[2]) * vv[2], gelu_tanh(a[3]) * vv[3]);
                    *(u32x2*)(H + (size_t)(T0 + k) * DFF + c) = w; }
            }
            asm volatile("" ::: "memory");
        }
    }
};

namespace att {
constexpr int NW = 8, QBLK = 32, KVBLK = 64, LDQ = 512;
constexpr float SCALE = 0.125f, THR = 8.f;
constexpr int SHM_V = KVBLK * 128 * 2, SHM_K = KVBLK * 64 * 2;
#define KSWZ(row, colB) ((row) * 128 + ((colB) ^ ((((row) >> 1) & 7) << 4)))
#define SBAR() __builtin_amdgcn_sched_barrier(0)
__device__ __forceinline__ int crow(int r, int hi) { return (r & 3) + 8 * (r >> 2) + 4 * hi; }
__device__ __forceinline__ void partialSM(f32x16& p0, f32x16& p1, float& m_ref, float& alpha, bool first) {
  constexpr float THRL = THR * 1.4426950408889634f;
  float pmax = p0[0];
#pragma unroll
  for (int r = 1; r < 16; ++r) pmax = fmaxf(pmax, p0[r]);
#pragma unroll
  for (int r = 0; r < 16; ++r) pmax = fmaxf(pmax, p1[r]);
  { auto rr = __builtin_amdgcn_permlane32_swap(__float_as_uint(pmax), __float_as_uint(pmax), false, false);
    pmax = fmaxf(__uint_as_float(rr[0]), __uint_as_float(rr[1])); }
  if (__builtin_expect(!first && __all(pmax <= THRL), 1)) { alpha = 1.f; }
  else { const float dl = first ? pmax : fmaxf(pmax, 0.f); m_ref += dl; alpha = first ? 1.f : __builtin_amdgcn_exp2f(-dl);
#pragma unroll
    for (int r = 0; r < 16; ++r) { p0[r] -= dl; p1[r] -= dl; } }
#pragma unroll
  for (int r = 0; r < 16; ++r) p0[r] = __builtin_amdgcn_exp2f(p0[r]);
}
__device__ __forceinline__ void finishSM(f32x16& p0, f32x16& p1, float alpha, float& l_reg, bf16x8& pa0, bf16x8& pa1, bf16x8& pa2, bf16x8& pa3) {
#pragma unroll
  for (int r = 0; r < 16; ++r) p1[r] = __builtin_amdgcn_exp2f(p1[r]);
  float ps = 0;
#pragma unroll
  for (int r = 0; r < 16; ++r) ps += p0[r];
#pragma unroll
  for (int r = 0; r < 16; ++r) ps += p1[r];
  { auto rr = __builtin_amdgcn_permlane32_swap(__float_as_uint(ps), __float_as_uint(ps), false, false);
    ps = __uint_as_float(rr[0]) + __uint_as_float(rr[1]); }
  l_reg = l_reg * alpha + ps;
#define PK4(P, BASE, OUT) do { unsigned a0 = cvt_pk_bf16(P[BASE + 0], P[BASE + 1]), a1 = cvt_pk_bf16(P[BASE + 2], P[BASE + 3]);   \
    unsigned b0 = cvt_pk_bf16(P[BASE + 4], P[BASE + 5]), b1 = cvt_pk_bf16(P[BASE + 6], P[BASE + 7]);                              \
    auto r0 = __builtin_amdgcn_permlane32_swap(a0, b0, false, false); auto r1 = __builtin_amdgcn_permlane32_swap(a1, b1, false, false); \
    u32x4 w = {r0[0], r1[0], r0[1], r1[1]}; OUT = *reinterpret_cast<bf16x8*>(&w); } while (0)
  PK4(p0, 0, pa0); PK4(p0, 8, pa1); PK4(p1, 0, pa2); PK4(p1, 8, pa3);
#undef PK4
}
__device__ __forceinline__ void qkt(f32x16& p0, f32x16& p1, const char* Ks, const bf16x8* qr, int r32, int hi, float m_ref) {
#pragma unroll
  for (int r = 0; r < 16; ++r) { p0[r] = -m_ref; p1[r] = -m_ref; }
#pragma unroll
  for (int d0 = 0; d0 < 4; ++d0) { const int cb = (d0 * 16 + hi * 8) * 2;
    bf16x8 b0 = *reinterpret_cast<const bf16x8*>(Ks + KSWZ(r32, cb));
    bf16x8 b1 = *reinterpret_cast<const bf16x8*>(Ks + KSWZ(32 + r32, cb));
    p0 = __builtin_amdgcn_mfma_f32_32x32x16_bf16(b0, qr[d0], p0, 0, 0, 0);
    p1 = __builtin_amdgcn_mfma_f32_32x32x16_bf16(b1, qr[d0], p1, 0, 0, 0); }
}
__device__ __forceinline__ int v_st(int k, int c) { const int kk = (k & ~0xC) | ((k & 4) << 1) | ((k & 8) >> 1); return ((kk >> 3) * 4 + (c >> 5)) * 512 + ((kk & 7) * 32 + (c & 31)) * 2; }
__device__ __forceinline__ int v_rd_base(int lane) { return ((lane & 3) << 3) | (((lane >> 2) & 3) << 6) | (((lane >> 4) & 1) << 5) | (((lane >> 5) & 1) << 8); }
constexpr int v_rd_off(int d0, int ks, int half) { return d0 * 512 + ks * 4096 + half * 2048; }
template <int OFF> __device__ __forceinline__ s16x4 tr_read(int vb) {
  s16x4 r; asm volatile("ds_read_b64_tr_b16 %0, %1 offset:%2" : "=&v"(r) : "v"(vb), "i"(OFF) : "memory"); return r;
}
template <int D0> __device__ __forceinline__ void pv_one(f32x16& od, int vb, bf16x8 pa0, bf16x8 pa1, bf16x8 pa2, bf16x8 pa3) {
  const s16x4 l0 = tr_read<v_rd_off(D0, 0, 0)>(vb), h0 = tr_read<v_rd_off(D0, 0, 1)>(vb), l1 = tr_read<v_rd_off(D0, 1, 0)>(vb), h1 = tr_read<v_rd_off(D0, 1, 1)>(vb);
  const s16x4 l2 = tr_read<v_rd_off(D0, 2, 0)>(vb), h2 = tr_read<v_rd_off(D0, 2, 1)>(vb), l3 = tr_read<v_rd_off(D0, 3, 0)>(vb), h3 = tr_read<v_rd_off(D0, 3, 1)>(vb);
  asm volatile("s_waitcnt lgkmcnt(0)" ::: "memory"); SBAR();
#define PK(L, H) (bf16x8){L[0], L[1], L[2], L[3], H[0], H[1], H[2], H[3]}
  od = __builtin_amdgcn_mfma_f32_32x32x16_bf16(pa0, PK(l0, h0), od, 0, 0, 0);
  od = __builtin_amdgcn_mfma_f32_32x32x16_bf16(pa1, PK(l1, h1), od, 0, 0, 0);
  od = __builtin_amdgcn_mfma_f32_32x32x16_bf16(pa2, PK(l2, h2), od, 0, 0, 0);
  od = __builtin_amdgcn_mfma_f32_32x32x16_bf16(pa3, PK(l3, h3), od, 0, 0, 0);
#undef PK
}
__device__ __forceinline__ void pv_d0(f32x16* o, int vb, bf16x8 pa0, bf16x8 pa1, bf16x8 pa2, bf16x8 pa3) {
  pv_one<0>(o[0], vb, pa0, pa1, pa2, pa3); pv_one<1>(o[1], vb, pa0, pa1, pa2, pa3); pv_one<2>(o[2], vb, pa0, pa1, pa2, pa3); pv_one<3>(o[3], vb, pa0, pa1, pa2, pa3);
}
__device__ __forceinline__ void attn_unit(const bf16_t* __restrict__ Qb, const bf16_t* __restrict__ Kh, const bf16_t* __restrict__ Vh, int seq, char* lds,
                                          int mode, float* scratch, float lam, float gscale, const float* __restrict__ subg, bf16_t* outp) {
  int tid_ = threadIdx.x; asm volatile("" : "+v"(tid_));
  const int tid = tid_, wid = tid >> 6, lane = tid & 63, r32 = lane & 31, hi = lane >> 5;
  char* V_lds = lds; char* K_lds = lds + 3 * SHM_V;
  float* ws = (float*)(lds + 3 * SHM_V + 3 * SHM_K) + wid * 64; float* li_l = ws; float* al_l = ws + 32;
  float m_reg = 0.f, l_reg = 0; f32x16 o[4] = {}; bf16x8 qr[4];
  const bf16_t* Qw = Qb + (long)(wid * QBLK + r32) * LDQ + hi * 8;
#pragma unroll
  for (int d0 = 0; d0 < 4; ++d0) qr[d0] = *reinterpret_cast<const bf16x8*>(Qw + d0 * 16);
  const int sr = tid >> 4, sc = (tid & 15) * 8, vst0 = v_st(sr, sc), vst1 = v_st(32 + sr, sc);
  const int kr = tid >> 3, kc = (tid & 7) * 8, kst = KSWZ(kr, kc * 2);
  const int vb0 = (int)(uintptr_t)V_lds + v_rd_base(lane);
  struct { bf16x8 vs0, vs1, ks0; } sr_[2];
#define SLOAD(i, k0) do { sr_[i].vs0 = *reinterpret_cast<const bf16x8*>(&Vh[(long)((k0) + sr) * LDQ + sc]); sr_[i].vs1 = *reinterpret_cast<const bf16x8*>(&Vh[(long)((k0) + 32 + sr) * LDQ + sc]); \
    sr_[i].ks0 = *reinterpret_cast<const bf16x8*>(&Kh[(long)((k0) + kr) * LDQ + kc]); } while (0)
#define SWRITE(b, i) do { *(bf16x8*)(V_lds + (b) * SHM_V + vst0) = sr_[i].vs0; *(bf16x8*)(V_lds + (b) * SHM_V + vst1) = sr_[i].vs1; \
    *(bf16x8*)(K_lds + (b) * SHM_K + kst) = sr_[i].ks0; } while (0)
#define SWAIT() asm volatile("s_waitcnt vmcnt(3)" ::: "memory")
#define RESC(a) do { if (__any((a) < 1.f)) { if (hi == 0) al_l[r32] = (a); asm volatile("s_waitcnt lgkmcnt(0)" ::: "memory"); \
    _Pragma("unroll") for (int d = 0; d < 4; ++d) _Pragma("unroll") for (int r = 0; r < 16; ++r) o[d][r] *= al_l[crow(r, hi)]; } } while (0)
  f32x16 pA0, pA1, pB0, pB1; float alA, alB; bf16x8 pa0, pa1, pa2, pa3; const int NT = seq / KVBLK;
  constexpr int SE = 0, SO = 1;
  SLOAD(SE, 0); asm volatile("s_waitcnt vmcnt(0)" ::: "memory"); SWRITE(0, SE); __syncthreads();
  qkt(pA0, pA1, K_lds, qr, r32, hi, m_reg); partialSM(pA0, pA1, m_reg, alA, true);
  SLOAD(SO, KVBLK); if (2 < NT) SLOAD(SE, 2 * KVBLK);
  SWAIT(); SWRITE(1, SO); __syncthreads();
  int bp = 0, bc = 1, bn = 2;
#define ROT3() do { const int t_ = bp; bp = bc; bc = bn; bn = t_; } while (0)
  if (wid >= 4) __builtin_amdgcn_s_setprio(1);
  for (int j = 1; j + 1 < NT; j += 2) {
    SBAR(); qkt(pB0, pB1, K_lds + bc * SHM_K, qr, r32, hi, m_reg);
    finishSM(pA0, pA1, alA, l_reg, pa0, pa1, pa2, pa3); SBAR();
    SLOAD(SO, (j + 2) * KVBLK); SBAR();
    pv_d0(o, vb0 + bp * SHM_V, pa0, pa1, pa2, pa3); partialSM(pB0, pB1, m_reg, alB, false);
    SWAIT(); SWRITE(bn, SE);
    RESC(alB); __syncthreads(); ROT3();
    SBAR(); qkt(pA0, pA1, K_lds + bc * SHM_K, qr, r32, hi, m_reg);
    finishSM(pB0, pB1, alB, l_reg, pa0, pa1, pa2, pa3); SBAR();
    if (j + 3 < NT) SLOAD(SE, (j + 3) * KVBLK); SBAR();
    pv_d0(o, vb0 + bp * SHM_V, pa0, pa1, pa2, pa3); partialSM(pA0, pA1, m_reg, alA, false);
    SWAIT(); SWRITE(bn, SO);
    RESC(alA); __syncthreads(); ROT3();
  }
  SBAR(); qkt(pB0, pB1, K_lds + bc * SHM_K, qr, r32, hi, m_reg);
  finishSM(pA0, pA1, alA, l_reg, pa0, pa1, pa2, pa3); SBAR();
  pv_d0(o, vb0 + bp * SHM_V, pa0, pa1, pa2, pa3); partialSM(pB0, pB1, m_reg, alB, false);
  RESC(alB);
  finishSM(pB0, pB1, alB, l_reg, pa0, pa1, pa2, pa3); SBAR();
  pv_d0(o, vb0 + bc * SHM_V, pa0, pa1, pa2, pa3);
  __builtin_amdgcn_s_setprio(0);
#undef ROT3
  if (hi == 0) li_l[r32] = l_reg; asm volatile("s_waitcnt lgkmcnt(0)" ::: "memory");
  float* sw = scratch + (long)(wid * QBLK) * 128;
  if (mode == 0) {
#pragma unroll
    for (int r = 0; r < 16; ++r) { const int orow = crow(r, hi); const float rl = __builtin_amdgcn_rcpf(li_l[orow]);
#pragma unroll
      for (int d0 = 0; d0 < 4; ++d0) sw[orow * 128 + d0 * 32 + r32] = o[d0][r] * rl; }
  } else {
    bf16_t* ow = outp + (long)(wid * QBLK) * 1024;
    float g4[4];
#pragma unroll
    for (int d0 = 0; d0 < 4; ++d0) g4[d0] = subg[d0 * 32 + r32] * gscale;
#pragma unroll
    for (int r = 0; r < 16; ++r) { const int orow = crow(r, hi); const float rl = __builtin_amdgcn_rcpf(li_l[orow]) * lam;
      float x[4]; float ss = 0.f;
#pragma unroll
      for (int d0 = 0; d0 < 4; ++d0) { x[d0] = sw[orow * 128 + d0 * 32 + r32] - o[d0][r] * rl; ss += x[d0] * x[d0]; }
      ss = sum32(ss);
      const float rn = rsqrtf(ss * (1.f / 128.f) + 1e-6f);
#pragma unroll
      for (int d0 = 0; d0 < 4; ++d0) ow[orow * 1024 + d0 * 32 + r32] = (bf16_t)f2bf(x[d0] * rn * g4[d0]); }
  }
  __syncthreads();
#undef SLOAD
#undef SWRITE
#undef SWAIT
#undef RESC
}
#undef KSWZ
#undef SBAR
}

namespace hg {
constexpr int ST = 65;
constexpr int O_Q = 0, O_K = 4160, O_B = 8320, O_QB = 12480, O_KS = 16640, O_V = 22880, O_S = 26976, O_TMP = 31072;
__device__ __forceinline__ int ksbase(int I) { return I == 0 ? O_KS : I == 1 ? O_KS + 16 * ST : I == 2 ? O_KS + 48 * ST : O_K; }
__device__ __forceinline__ f32x4 mm4(float a, float b, f32x4 c) { return __builtin_amdgcn_mfma_f32_16x16x4f32(a, b, c, 0, 0, 0); }
__device__ __forceinline__ void load_gates(LAS float* sm, const float* ZF, const float* lbt, int tok0, int h, int dir, int tid) {
    const int tl = tid >> 3, c8 = (tid & 7) * 8, j = dir ? 63 - tl : tl;
    const float* zp = ZF + (size_t)(tok0 + tl) * 256 + h * 64 + c8;
    const f32x4 z0 = *(const f32x4*)zp, z1 = *(const f32x4*)(zp + 4);
    const f32x4 l0 = *(const f32x4*)(lbt + h * 64 + c8), l1 = *(const f32x4*)(lbt + h * 64 + c8 + 4);
    const float z[8] = {z0[0], z0[1], z0[2], z0[3], z1[0], z1[1], z1[2], z1[3]}, lb[8] = {l0[0], l0[1], l0[2], l0[3], l1[0], l1[1], l1[2], l1[3]};
#pragma unroll
    for (int e = 0; e < 8; ++e) { const float sg = __builtin_amdgcn_rcpf(1.f + __expf(-z[e])); const float f = lb[e] + (1.f - lb[e]) * sg;
        sm[O_B + j * ST + c8 + e] = __logf(f); sm[O_K + j * ST + c8 + e] = (1.f - lb[e]) * __builtin_amdgcn_rcpf(1.f + __expf(z[e])); }
}
__device__ __forceinline__ void cumsum_b(LAS float* sm, int tid) {
    const int d = tid & 63, seg = tid >> 6; float run = 0.f;
#pragma unroll
    for (int r = 0; r < 8; ++r) { const int ix = O_B + (seg * 8 + r) * ST + d; run += sm[ix]; sm[ix] = run; }
    sm[O_TMP + seg * 64 + d] = run;
    __syncthreads();
    float off = 0.f;
    for (int s = 0; s < seg; ++s) off += sm[O_TMP + s * 64 + d];
#pragma unroll
    for (int r = 0; r < 8; ++r) sm[O_B + (seg * 8 + r) * ST + d] += off;
    __syncthreads();
}
__device__ __forceinline__ void load_bf16_tile(LAS float* dst, int stride, const bf16_t* src, int tok0, int h, int dir, int tid) {
    const int tl = tid >> 3, c8 = (tid & 7) * 8, j = dir ? 63 - tl : tl;
    const u32x4 w = *(const u32x4*)(src + (size_t)(tok0 + tl) * 256 + h * 64 + c8); float v[8]; unpack8(w, v);
#pragma unroll
    for (int e = 0; e < 8; ++e) dst[j * stride + c8 + e] = v[e];
}
__device__ __forceinline__ void unit_a(LAS float* sm, int u, const float* ZF0, const float* ZF1, const bf16_t* HI, const float* lbt, float* STB, float* HD) {
    const int tid = ltid(), lane = tid & 63, w = tid >> 6; const int chunk = u & 255, dir = (u >> 8) & 1, h = (u >> 9) & 3, b = u >> 11;
    const int tok0 = b * SEQ + chunk * 64;
    load_gates(sm, dir ? ZF1 : ZF0, lbt + dir * 256, tok0, h, dir, tid);
    load_bf16_tile(sm + O_V, 64, HI, tok0, h, dir, tid);
    __syncthreads();
    cumsum_b(sm, tid);
    { const int d = tid & 63, seg = tid >> 6; const float bl = sm[O_B + 63 * ST + d];
#pragma unroll
      for (int r = 0; r < 8; ++r) { const int ix = (seg * 8 + r) * ST + d; sm[O_K + ix] *= __expf(bl - sm[O_B + ix]); } }
    __syncthreads();
    const int stream = (b * 4 + h) * 2 + dir, p = dir ? 255 - chunk : chunk;
    const int fr = lane & 15, fq = lane >> 4;
#pragma unroll
    for (int tt = 0; tt < 2; ++tt) { const int T = 2 * w + tt, di = T >> 2, ei = T & 3; f32x4 acc = {0.f, 0.f, 0.f, 0.f};
#pragma unroll 4
        for (int k0 = 0; k0 < 64; k0 += 4) acc = mm4(sm[O_K + (k0 + fq) * ST + 16 * di + fr], sm[O_V + (k0 + fq) * 64 + 16 * ei + fr], acc);
        asm volatile("s_nop 15\n\ts_nop 7" : "+v"(acc));
        float* up = STB + ((size_t)(stream * 256 + p)) * 4096 + (16 * di + 4 * fq) * 64 + 16 * ei + fr;
#pragma unroll
        for (int r = 0; r < 4; ++r) up[r * 64] = acc[r]; }
    if (tid < 64) HD[(size_t)(stream * 256 + p) * 64 + tid] = __expf(sm[O_B + 63 * ST + tid]);
    __syncthreads();
}
struct PreA { f32x4 z0, z1; u32x4 v; };
__device__ __forceinline__ PreA issue_a(int u, const float* ZF0, const float* ZF1, const bf16_t* HI, int tid) {
    const int chunk = u & 255, dir = (u >> 8) & 1, h = (u >> 9) & 3, b = u >> 11; const int tok0 = b * SEQ + chunk * 64; const int tl = tid >> 3, c8 = (tid & 7) * 8;
    const float* zp = (dir ? ZF1 : ZF0) + (size_t)(tok0 + tl) * 256 + h * 64 + c8;
    PreA p; p.z0 = *(const f32x4*)zp; p.z1 = *(const f32x4*)(zp + 4); p.v = *(const u32x4*)(HI + (size_t)(tok0 + tl) * 256 + h * 64 + c8); return p;
}
__device__ __forceinline__ void unit_a_pre(LAS float* sm, int u, const PreA& pre, const float* lbt0, float* STB, float* HD, int tid) {
    const int lane = tid & 63, w = __builtin_amdgcn_readfirstlane(tid >> 6); const int chunk = u & 255, dir = (u >> 8) & 1, h = (u >> 9) & 3, b = u >> 11;
    { const int tl = tid >> 3, c8 = (tid & 7) * 8, j = dir ? 63 - tl : tl; const float* lbt = lbt0 + dir * 256;
      const f32x4 l0 = *(const f32x4*)(lbt + h * 64 + c8), l1 = *(const f32x4*)(lbt + h * 64 + c8 + 4);
      const float z[8] = {pre.z0[0], pre.z0[1], pre.z0[2], pre.z0[3], pre.z1[0], pre.z1[1], pre.z1[2], pre.z1[3]}, lb[8] = {l0[0], l0[1], l0[2], l0[3], l1[0], l1[1], l1[2], l1[3]};
      float v[8]; unpack8(pre.v, v);
#pragma unroll
      for (int e = 0; e < 8; ++e) { const float sg = __builtin_amdgcn_rcpf(1.f + __expf(-z[e])); const float f = lb[e] + (1.f - lb[e]) * sg;
          sm[O_B + j * ST + c8 + e] = __logf(f); sm[O_K + j * ST + c8 + e] = (1.f - lb[e]) * __builtin_amdgcn_rcpf(1.f + __expf(z[e])); sm[O_V + j * 64 + c8 + e] = v[e]; } }
    __syncthreads();
    cumsum_b(sm, tid);
    { const int d = tid & 63, seg = tid >> 6; const float bl = sm[O_B + 63 * ST + d];
#pragma unroll
      for (int r = 0; r < 8; ++r) { const int ix = (seg * 8 + r) * ST + d; sm[O_K + ix] *= __expf(bl - sm[O_B + ix]); } }
    __syncthreads();
    const int stream = (b * 4 + h) * 2 + dir, p = dir ? 255 - chunk : chunk;
    const int fr = lane & 15, fq = lane >> 4;
#pragma unroll
    for (int tt = 0; tt < 2; ++tt) { const int T = 2 * w + tt, di = T >> 2, ei = T & 3; f32x4 acc = {0.f, 0.f, 0.f, 0.f};
#pragma unroll 4
        for (int k0 = 0; k0 < 64; k0 += 4) acc = mm4(sm[O_K + (k0 + fq) * ST + 16 * di + fr], sm[O_V + (k0 + fq) * 64 + 16 * ei + fr], acc);
        asm volatile("s_nop 15\n\ts_nop 7" : "+v"(acc));
        float* up = STB + ((size_t)(stream * 256 + p)) * 4096 + (16 * di + 4 * fq) * 64 + 16 * ei + fr;
#pragma unroll
        for (int r = 0; r < 4; ++r) up[r * 64] = acc[r]; }
    if (tid < 64) HD[(size_t)(stream * 256 + p) * 64 + tid] = __expf(sm[O_B + 63 * ST + tid]);
    __syncthreads();
}
__device__ __forceinline__ void phase_a(LAS float* sm, int bx, int G, const float* ZF0, const float* ZF1, const bf16_t* HI, const float* lbt0, float* STB, float* HD) {
    const int tid = ltid(); int u = bx; if (u >= 4096) return;
    PreA pre = issue_a(u, ZF0, ZF1, HI, tid);
#pragma unroll 1
    for (; u < 4096; u += G) { PreA nxt = pre; if (u + G < 4096) nxt = issue_a(u + G, ZF0, ZF1, HI, tid);
        unit_a_pre(sm, u, pre, lbt0, STB, HD, tid); pre = nxt; }
}
__device__ __forceinline__ void phase_b(float* STB, const float* HD) {
    const int gid = lbid() * 512 + ltid(); if (gid >= 65536) return;
    const int stream = gid >> 12, de = gid & 4095, d = de >> 6;
    float* sp = STB + (size_t)stream * 256 * 4096 + de; const float* dp = HD + (size_t)stream * 256 * 64 + d;
    float S = 0.f;
    for (int p = 0; p < 256; p += 32) {
        float uu[32], dc[32];
#pragma unroll
        for (int i = 0; i < 32; ++i) { uu[i] = sp[(size_t)(p + i) * 4096]; dc[i] = dp[(p + i) * 64]; }
#pragma unroll
        for (int i = 0; i < 32; ++i) { sp[(size_t)(p + i) * 4096] = S; S = dc[i] * S + uu[i]; }
    }
}
__device__ __forceinline__ void unit_c(LAS float* sm, int u, const float* ZF0, const float* ZF1, const bf16_t* HQ, const bf16_t* HI, const bf16_t* HGs, const float* lbt, const float* STB,
                                       const float* normg, bf16_t* MIX) {
    const int tid = ltid(), lane = tid & 63, w = tid >> 6; const int chunk = u & 255, h = (u >> 8) & 3, b = u >> 10;
    const int tok0 = b * SEQ + chunk * 64; const int fr = lane & 15, fq = lane >> 4;
    f32x4 oacc[2] = {{0.f, 0.f, 0.f, 0.f}, {0.f, 0.f, 0.f, 0.f}};
#pragma unroll 1
    for (int dir = 0; dir < 2; ++dir) {
        load_gates(sm, dir ? ZF1 : ZF0, lbt + dir * 256, tok0, h, dir, tid);
        load_bf16_tile(sm + O_Q, ST, HQ, tok0, h, dir, tid);
        load_bf16_tile(sm + O_V, 64, HI, tok0, h, dir, tid);
        { const int stream = (b * 4 + h) * 2 + dir, p = dir ? 255 - chunk : chunk; const float* sp = STB + ((size_t)(stream * 256 + p)) * 4096 + tid * 8;
          *(LAS f32x4*)(sm + O_S + tid * 8) = *(const f32x4*)sp; *(LAS f32x4*)(sm + O_S + tid * 8 + 4) = *(const f32x4*)(sp + 4); }
        __syncthreads();
        cumsum_b(sm, tid);
        { const int d = tid & 63, seg = tid >> 6, I = seg >> 1;
          float rj[4]; rj[0] = 0.f; rj[1] = sm[O_B + 15 * ST + d]; rj[2] = sm[O_B + 31 * ST + d]; rj[3] = sm[O_B + 47 * ST + d];
#pragma unroll
          for (int r = 0; r < 8; ++r) { const int ix = (seg * 8 + r) * ST + d; const float bt = sm[O_B + ix], q = sm[O_Q + ix], k = sm[O_K + ix];
              sm[O_QB + ix] = q * __expf(bt);
              sm[O_Q + ix] = q * __expf(bt - (I == 0 ? rj[0] : I == 1 ? rj[1] : I == 2 ? rj[2] : rj[3]));
#pragma unroll
              for (int J = 0; J < 4; ++J) if (J >= I) sm[ksbase(J) + ix] = k * __expf(fminf(rj[J] - bt, 80.f)); } }
        __syncthreads();
#pragma unroll 1
        for (int T = w; T < 10; T += 8) {
            const int I = T < 1 ? 0 : T < 3 ? 1 : T < 6 ? 2 : 3, J = T - (I * (I + 1)) / 2; const int kb = ksbase(I); f32x4 acc = {0.f, 0.f, 0.f, 0.f};
#pragma unroll 4
            for (int k0 = 0; k0 < 64; k0 += 4) acc = mm4(sm[O_Q + (16 * I + fr) * ST + k0 + fq], sm[kb + (16 * J + fr) * ST + k0 + fq], acc);
            asm volatile("s_nop 15\n\ts_nop 7" : "+v"(acc));
#pragma unroll
            for (int r = 0; r < 4; ++r) { const int t = 16 * I + 4 * fq + r, sx = 16 * J + fr; sm[O_B + t * ST + sx] = (sx <= t) ? acc[r] : 0.f; } }
        __syncthreads();
#pragma unroll
        for (int tt = 0; tt < 2; ++tt) { const int T = 2 * w + tt, ti = T >> 2, ei = T & 3; const int j = dir ? 63 - (16 * ti + fr) : 16 * ti + fr; const int ks = dir ? 4 * (4 - ti) : 4 * (ti + 1);
            f32x4 acc = {0.f, 0.f, 0.f, 0.f};
#pragma unroll 4
            for (int k0 = 0; k0 < 64; k0 += 4) acc = mm4(sm[O_QB + j * ST + k0 + fq], sm[O_S + (k0 + fq) * 64 + 16 * ei + fr], acc);
            for (int kk = 0; kk < ks; ++kk) acc = mm4(sm[O_B + j * ST + 4 * kk + fq], sm[O_V + (4 * kk + fq) * 64 + 16 * ei + fr], acc);
            asm volatile("s_nop 15\n\ts_nop 7" : "+v"(acc)); oacc[tt] += acc; }
        __syncthreads();
    }
#pragma unroll
    for (int tt = 0; tt < 2; ++tt) { const int T = 2 * w + tt, ti = T >> 2, ei = T & 3;
#pragma unroll
        for (int r = 0; r < 4; ++r) sm[O_Q + (16 * ti + 4 * fq + r) * ST + 16 * ei + fr] = oacc[tt][r]; }
    __syncthreads();
    const int tl = tid >> 3, e0 = (tid & 7) * 8;
    float ov[8]; float ss = 0.f;
#pragma unroll
    for (int e = 0; e < 8; ++e) { ov[e] = sm[O_Q + tl * ST + e0 + e]; ss += ov[e] * ov[e]; }
    ss = sum8(ss);
    const float rn = rsqrtf(ss * (1.f / 64.f) + 1e-6f);
    const size_t tok = (size_t)(tok0 + tl);
    float gv[8]; unpack8(*(const u32x4*)(HGs + tok * 256 + h * 64 + e0), gv);
    const f32x4 n0 = *(const f32x4*)(normg + h * 64 + e0), n1 = *(const f32x4*)(normg + h * 64 + e0 + 4);
    const float ng[8] = {n0[0], n0[1], n0[2], n0[3], n1[0], n1[1], n1[2], n1[3]};
#pragma unroll
    for (int e = 0; e < 8; ++e) ov[e] = ov[e] * rn * ng[e] * gv[e];
    st8_bf16(MIX + tok * 1024 + h * 64 + e0, ov);
    __syncthreads();
}
struct PreC { f32x4 z0, z1, s0, s1; u32x4 q, v; };
__device__ __forceinline__ PreC issue_c(int u, int dir, const float* ZF0, const float* ZF1, const bf16_t* HQ, const bf16_t* HI, const float* STB, int tid) {
    const int chunk = u & 255, h = (u >> 8) & 3, b = u >> 10; const int tok0 = b * SEQ + chunk * 64; const int tl = tid >> 3, c8 = (tid & 7) * 8;
    const float* zp = (dir ? ZF1 : ZF0) + (size_t)(tok0 + tl) * 256 + h * 64 + c8;
    const int stream = (b * 4 + h) * 2 + dir, p = dir ? 255 - chunk : chunk; const float* sp = STB + ((size_t)(stream * 256 + p)) * 4096 + tid * 8;
    PreC r; r.z0 = *(const f32x4*)zp; r.z1 = *(const f32x4*)(zp + 4); r.q = *(const u32x4*)(HQ + (size_t)(tok0 + tl) * 256 + h * 64 + c8); r.v = *(const u32x4*)(HI + (size_t)(tok0 + tl) * 256 + h * 64 + c8);
    r.s0 = *(const f32x4*)sp; r.s1 = *(const f32x4*)(sp + 4); return r;
}
__device__ __forceinline__ void phase_c(LAS float* sm, int bx, int G, const float* ZF0, const float* ZF1, const bf16_t* HQ, const bf16_t* HI, const bf16_t* HGs, const float* lbt, const float* STB,
                                        const float* normg, bf16_t* MIX) {
    const int tid = ltid(), lane = tid & 63, w = __builtin_amdgcn_readfirstlane(tid >> 6); const int fr = lane & 15, fq = lane >> 4;
    int u = bx; if (u >= 2048) return;
    PreC pre = issue_c(u, 0, ZF0, ZF1, HQ, HI, STB, tid);
#pragma unroll 1
    for (; u < 2048; u += G) {
    const int chunk = u & 255, h = (u >> 8) & 3, b = u >> 10; const int tok0 = b * SEQ + chunk * 64;
    f32x4 oacc[2] = {{0.f, 0.f, 0.f, 0.f}, {0.f, 0.f, 0.f, 0.f}};
#pragma unroll 1
    for (int dir = 0; dir < 2; ++dir) {
        {
            const int tl = tid >> 3, c8 = (tid & 7) * 8, j = dir ? 63 - tl : tl; const float* lbd = lbt + dir * 256;
            const f32x4 l0 = *(const f32x4*)(lbd + h * 64 + c8), l1 = *(const f32x4*)(lbd + h * 64 + c8 + 4);
            const float z[8] = {pre.z0[0], pre.z0[1], pre.z0[2], pre.z0[3], pre.z1[0], pre.z1[1], pre.z1[2], pre.z1[3]}, lb[8] = {l0[0], l0[1], l0[2], l0[3], l1[0], l1[1], l1[2], l1[3]};
            float qv[8], vv[8]; unpack8(pre.q, qv); unpack8(pre.v, vv);
#pragma unroll
            for (int e = 0; e < 8; ++e) { const float sg = __builtin_amdgcn_rcpf(1.f + __expf(-z[e])); const float f = lb[e] + (1.f - lb[e]) * sg;
                sm[O_B + j * ST + c8 + e] = __logf(f); sm[O_K + j * ST + c8 + e] = (1.f - lb[e]) * __builtin_amdgcn_rcpf(1.f + __expf(z[e]));
                sm[O_Q + j * ST + c8 + e] = qv[e]; sm[O_V + j * 64 + c8 + e] = vv[e]; }
            *(LAS f32x4*)(sm + O_S + tid * 8) = pre.s0; *(LAS f32x4*)(sm + O_S + tid * 8 + 4) = pre.s1;
            if (dir == 0) pre = issue_c(u, 1, ZF0, ZF1, HQ, HI, STB, tid); else if (u + G < 2048) pre = issue_c(u + G, 0, ZF0, ZF1, HQ, HI, STB, tid);
        }
        __syncthreads();
        cumsum_b(sm, tid);
        { const int d = tid & 63, seg = tid >> 6, I = seg >> 1;
          float rj[4]; rj[0] = 0.f; rj[1] = sm[O_B + 15 * ST + d]; rj[2] = sm[O_B + 31 * ST + d]; rj[3] = sm[O_B + 47 * ST + d];
#pragma unroll
          for (int r = 0; r < 8; ++r) { const int ix = (seg * 8 + r) * ST + d; const float bt = sm[O_B + ix], q = sm[O_Q + ix], k = sm[O_K + ix];
              sm[O_QB + ix] = q * __expf(bt);
              sm[O_Q + ix] = q * __expf(bt - (I == 0 ? rj[0] : I == 1 ? rj[1] : I == 2 ? rj[2] : rj[3]));
#pragma unroll
              for (int J = 0; J < 4; ++J) if (J >= I) sm[ksbase(J) + ix] = k * __expf(fminf(rj[J] - bt, 80.f)); } }
        __syncthreads();
#pragma unroll 1
        for (int T = w; T < 10; T += 8) {
            const int I = T < 1 ? 0 : T < 3 ? 1 : T < 6 ? 2 : 3, J = T - (I * (I + 1)) / 2; const int kb = ksbase(I); f32x4 acc = {0.f, 0.f, 0.f, 0.f};
#pragma unroll 4
            for (int k0 = 0; k0 < 64; k0 += 4) acc = mm4(sm[O_Q + (16 * I + fr) * ST + k0 + fq], sm[kb + (16 * J + fr) * ST + k0 + fq], acc);
            asm volatile("s_nop 15\n\ts_nop 7" : "+v"(acc));
#pragma unroll
            for (int r = 0; r < 4; ++r) { const int t = 16 * I + 4 * fq + r, sx = 16 * J + fr; sm[O_B + t * ST + sx] = (sx <= t) ? acc[r] : 0.f; } }
        __syncthreads();
#pragma unroll
        for (int tt = 0; tt < 2; ++tt) { const int T = 2 * w + tt, ti = T >> 2, ei = T & 3; const int j = dir ? 63 - (16 * ti + fr) : 16 * ti + fr; const int ks = dir ? 4 * (4 - ti) : 4 * (ti + 1);
            f32x4 acc = {0.f, 0.f, 0.f, 0.f};
#pragma unroll 4
            for (int k0 = 0; k0 < 64; k0 += 4) acc = mm4(sm[O_QB + j * ST + k0 + fq], sm[O_S + (k0 + fq) * 64 + 16 * ei + fr], acc);
            for (int kk = 0; kk < ks; ++kk) acc = mm4(sm[O_B + j * ST + 4 * kk + fq], sm[O_V + (4 * kk + fq) * 64 + 16 * ei + fr], acc);
            asm volatile("s_nop 15\n\ts_nop 7" : "+v"(acc)); oacc[tt] += acc; }
        __syncthreads();
    }
#pragma unroll
    for (int tt = 0; tt < 2; ++tt) { const int T = 2 * w + tt, ti = T >> 2, ei = T & 3;
#pragma unroll
        for (int r = 0; r < 4; ++r) sm[O_Q + (16 * ti + 4 * fq + r) * ST + 16 * ei + fr] = oacc[tt][r]; }
    const int tl = tid >> 3, e0 = (tid & 7) * 8;
    const u32x4 hgw = *(const u32x4*)(HGs + (size_t)(tok0 + tl) * 256 + h * 64 + e0);
    const f32x4 n0 = *(const f32x4*)(normg + h * 64 + e0), n1 = *(const f32x4*)(normg + h * 64 + e0 + 4);
    __syncthreads();
    float ov[8]; float ss = 0.f;
#pragma unroll
    for (int e = 0; e < 8; ++e) { ov[e] = sm[O_Q + tl * ST + e0 + e]; ss += ov[e] * ov[e]; }
    ss = sum8(ss);
    const float rn = rsqrtf(ss * (1.f / 64.f) + 1e-6f);
    const size_t tok = (size_t)(tok0 + tl);
    float gv[8]; unpack8(hgw, gv);
    const float ng[8] = {n0[0], n0[1], n0[2], n0[3], n1[0], n1[1], n1[2], n1[3]};
#pragma unroll
    for (int e = 0; e < 8; ++e) ov[e] = ov[e] * rn * ng[e] * gv[e];
    st8_bf16(MIX + tok * 1024 + h * 64 + e0, ov);
    __syncthreads();
    }
}
}

namespace rg {
constexpr int XS = 65, XBS = 72;
constexpr int OB_XC = 0, OB_XB = 33280, OB_WT = 51712, OB_AGG = 88576;
struct PreR { f32x4 x[2][4][2]; };
__device__ __forceinline__ PreR issue_r(int u, const float* RX, int tid) {
    const int chunk = u & 127, n = (u >> 7) & 3, b = u >> 9; const int t0 = chunk * 128; PreR r;
#pragma unroll
    for (int i2 = 0; i2 < 2; ++i2) { const int it = tid + i2 * 512; const int tl = it >> 3, c8 = (it & 7) * 8; const int ch = n * 64 + c8;
#pragma unroll
        for (int jj = 0; jj < 4; ++jj) { const int t = t0 + tl - 2 + jj; const bool ok = (t >= 0 && t < SEQ);
            const float* xp = RX + ((size_t)b * SEQ + (ok ? t : 0)) * 256 + ch;
            const f32x4 x0 = *(const f32x4*)xp, x1 = *(const f32x4*)(xp + 4); const f32x4 zz = {0.f, 0.f, 0.f, 0.f};
            r.x[i2][jj][0] = ok ? x0 : zz; r.x[i2][jj][1] = ok ? x1 : zz; } }
    return r;
}
template <bool FULL>
__device__ __forceinline__ void unit(LAS unsigned char* smb, int u, const float* RX, const bf16_t* RYg, const float* cw, const float* cb, const bf16_t* RGW, const float* ba, const float* bx,
                                     const float* lamp, float* AGG, const float* CAR, bf16_t* MIX) {
    const int tid = ltid(), lane = tid & 63, w = tid >> 6, fr = lane & 15, fq = lane >> 4; const int chunk = u & 127, n = (u >> 7) & 3, b = u >> 9;
    const int t0 = chunk * 128;
    LAS float* sxc = (LAS float*)(smb + OB_XC); LAS float* sag = (LAS float*)(smb + OB_AGG);
    { const bf16_t* src = RGW + (size_t)n * 16384;
#pragma unroll
      for (int q = 0; q < 4; ++q) { const int cidx = tid + q * 512, row = cidx >> 3, c8 = (cidx & 7) * 8;
          *(LAS u32x4*)(smb + OB_WT + (row * XBS + c8) * 2) = *(const u32x4*)(src + (size_t)row * 64 + c8); } }
    for (int it = tid; it < 128 * 8; it += 512) { const int tl = it >> 3, c8 = (it & 7) * 8; const int ch = n * 64 + c8;
        float a[8];
        { const f32x4 b0 = *(const f32x4*)(cb + ch), b1 = *(const f32x4*)(cb + ch + 4); a[0] = b0[0]; a[1] = b0[1]; a[2] = b0[2]; a[3] = b0[3]; a[4] = b1[0]; a[5] = b1[1]; a[6] = b1[2]; a[7] = b1[3]; }
#pragma unroll
        for (int jj = 0; jj < 4; ++jj) { const int t = t0 + tl - 2 + jj; if (t < 0 || t >= SEQ) continue;
            const float* xp = RX + ((size_t)b * SEQ + t) * 256 + ch; const f32x4 x0 = *(const f32x4*)xp, x1 = *(const f32x4*)(xp + 4);
            const f32x4 w0 = *(const f32x4*)(cw + jj * 256 + ch), w1 = *(const f32x4*)(cw + jj * 256 + ch + 4);
            a[0] += w0[0] * x0[0]; a[1] += w0[1] * x0[1]; a[2] += w0[2] * x0[2]; a[3] += w0[3] * x0[3]; a[4] += w1[0] * x1[0]; a[5] += w1[1] * x1[1]; a[6] += w1[2] * x1[2]; a[7] += w1[3] * x1[3]; }
#pragma unroll
        for (int e = 0; e < 8; ++e) sxc[tl * XS + c8 + e] = a[e];
        *(LAS u32x4*)(smb + OB_XB + (tl * XBS + c8) * 2) = pack8(a); }
    __syncthreads();
    f32x4 acc[4][4];
    { const bf16x8 a0 = *(const LAS bf16x8*)(smb + OB_XB + ((16 * w + fr) * XBS + 8 * fq) * 2), a1 = *(const LAS bf16x8*)(smb + OB_XB + ((16 * w + fr) * XBS + 32 + 8 * fq) * 2);
#pragma unroll
      for (int g = 0; g < 4; ++g)
#pragma unroll
          for (int cg = 0; cg < 4; ++cg) { const int wb = OB_WT + ((g * 64 + 16 * cg + fr) * XBS + 8 * fq) * 2;
              const bf16x8 b0 = *(const LAS bf16x8*)(smb + wb), b1 = *(const LAS bf16x8*)(smb + wb + 64);
              f32x4 c = {0.f, 0.f, 0.f, 0.f}; c = __builtin_amdgcn_mfma_f32_16x16x32_bf16(a0, b0, c, 0, 0, 0); acc[g][cg] = __builtin_amdgcn_mfma_f32_16x16x32_bf16(a1, b1, c, 0, 0, 0); } }
    float av0[16], uv0[16], av1[16], uv1[16];
    const int run = 4 * w + fq;
#pragma unroll
    for (int cg = 0; cg < 4; ++cg) { const int ch = n * 64 + 16 * cg + fr;
        const float ba0 = ba[ch], ba1 = ba[256 + ch], bx0 = bx[ch], bx1 = bx[256 + ch];
        const float sp0 = log1pf(__expf(-lamp[ch])), sp1 = log1pf(__expf(-lamp[256 + ch]));
        float Af = 1.f, Bf = 0.f, Ab = 1.f, Bb = 0.f;
#pragma unroll
        for (int r = 0; r < 4; ++r) { const float xc = sxc[(16 * w + 4 * fq + r) * XS + 16 * cg + fr];
            { const float rr = sigm(acc[0][cg][r] + ba0), ig = sigm(acc[2][cg][r] + bx0); const float la = -8.f * rr * sp0; av0[cg * 4 + r] = __expf(la); uv0[cg * 4 + r] = __builtin_amdgcn_sqrtf(nexpm1(2.f * la)) * (ig * xc); }
            { const float rr = sigm(acc[1][cg][r] + ba1), ig = sigm(acc[3][cg][r] + bx1); const float la = -8.f * rr * sp1; av1[cg * 4 + r] = __expf(la); uv1[cg * 4 + r] = __builtin_amdgcn_sqrtf(nexpm1(2.f * la)) * (ig * xc); }
            Bf = av0[cg * 4 + r] * Bf + uv0[cg * 4 + r]; Af *= av0[cg * 4 + r]; Bb += Ab * uv1[cg * 4 + r]; Ab *= av1[cg * 4 + r]; }
        sag[((0 * 32 + run) * 64 + 16 * cg + fr) * 2] = Af; sag[((0 * 32 + run) * 64 + 16 * cg + fr) * 2 + 1] = Bf;
        sag[((1 * 32 + run) * 64 + 16 * cg + fr) * 2] = Ab; sag[((1 * 32 + run) * 64 + 16 * cg + fr) * 2 + 1] = Bb; }
    __syncthreads();
    if (tid < 128) { const int dir = tid >> 6, j = tid & 63, ch = n * 64 + j;
        if (!FULL) { float A = 1.f, Bv = 0.f;
            if (dir == 0) { for (int s = 0; s < 32; ++s) { const float a = sag[((0 * 32 + s) * 64 + j) * 2], bb = sag[((0 * 32 + s) * 64 + j) * 2 + 1]; Bv = a * Bv + bb; A *= a; } }
            else { for (int s = 31; s >= 0; --s) { const float a = sag[((1 * 32 + s) * 64 + j) * 2], bb = sag[((1 * 32 + s) * 64 + j) * 2 + 1]; Bv = a * Bv + bb; A *= a; } }
            float* ap = AGG + ((size_t)((b * 2 + dir) * 128 + chunk) * 256 + ch) * 2; ap[0] = A; ap[1] = Bv;
        } else { float hc = CAR[(size_t)((b * 2 + dir) * 128 + chunk) * 256 + ch];
            if (dir == 0) { for (int s = 0; s < 32; ++s) { const int ix = ((0 * 32 + s) * 64 + j) * 2; const float a = sag[ix], bb = sag[ix + 1]; sag[ix] = hc; hc = a * hc + bb; } }
            else { for (int s = 31; s >= 0; --s) { const int ix = ((1 * 32 + s) * 64 + j) * 2; const float a = sag[ix], bb = sag[ix + 1]; sag[ix] = hc; hc = a * hc + bb; } } } }
    if (FULL) {
        __syncthreads();
        const size_t tokb = (size_t)b * SEQ + t0 + 16 * w + 4 * fq;
#pragma unroll
        for (int cg = 0; cg < 4; ++cg) { const int ch = n * 64 + 16 * cg + fr;
            float hf = sag[((0 * 32 + run) * 64 + 16 * cg + fr) * 2], hb = sag[((1 * 32 + run) * 64 + 16 * cg + fr) * 2]; float hs[4];
#pragma unroll
            for (int r = 0; r < 4; ++r) { hf = av0[cg * 4 + r] * hf + uv0[cg * 4 + r]; hs[r] = hf; }
#pragma unroll
            for (int r = 3; r >= 0; --r) { hb = av1[cg * 4 + r] * hb + uv1[cg * 4 + r]; hs[r] += hb; }
#pragma unroll
            for (int r = 0; r < 4; ++r) { const float y = bf2f(RYg[(tokb + r) * 256 + ch]); MIX[(tokb + r) * 1024 + 256 + ch] = (bf16_t)f2bf(hs[r] * y); } }
    }
    __syncthreads();
}
template <bool FULL>
__device__ __forceinline__ void unit_pre(LAS unsigned char* smb, int u, const PreR& pre, int pre_tid, const bf16_t* RYg, const float* cw, const float* cb, const bf16_t* RGW, const float* ba, const float* bx,
                                     const float* lamp, float* AGG, const float* CAR, bf16_t* MIX) {
    const int tid = pre_tid, lane = tid & 63, w = __builtin_amdgcn_readfirstlane(tid >> 6), fr = lane & 15, fq = lane >> 4; const int chunk = u & 127, n = (u >> 7) & 3, b = u >> 9;
    const int t0 = chunk * 128;
    LAS float* sxc = (LAS float*)(smb + OB_XC); LAS float* sag = (LAS float*)(smb + OB_AGG);
    { const bf16_t* src = RGW + (size_t)n * 16384;
#pragma unroll
      for (int q = 0; q < 4; ++q) { const int cidx = tid + q * 512, row = cidx >> 3, c8 = (cidx & 7) * 8;
          *(LAS u32x4*)(smb + OB_WT + (row * XBS + c8) * 2) = *(const u32x4*)(src + (size_t)row * 64 + c8); } }
#pragma unroll
    for (int i2 = 0; i2 < 2; ++i2) { const int it = tid + i2 * 512; const int tl = it >> 3, c8 = (it & 7) * 8; const int ch = n * 64 + c8;
        float a[8];
        { const f32x4 b0 = *(const f32x4*)(cb + ch), b1 = *(const f32x4*)(cb + ch + 4); a[0] = b0[0]; a[1] = b0[1]; a[2] = b0[2]; a[3] = b0[3]; a[4] = b1[0]; a[5] = b1[1]; a[6] = b1[2]; a[7] = b1[3]; }
#pragma unroll
        for (int jj = 0; jj < 4; ++jj) { const f32x4 x0 = pre.x[i2][jj][0], x1 = pre.x[i2][jj][1];
            const f32x4 w0 = *(const f32x4*)(cw + jj * 256 + ch), w1 = *(const f32x4*)(cw + jj * 256 + ch + 4);
            a[0] += w0[0] * x0[0]; a[1] += w0[1] * x0[1]; a[2] += w0[2] * x0[2]; a[3] += w0[3] * x0[3]; a[4] += w1[0] * x1[0]; a[5] += w1[1] * x1[1]; a[6] += w1[2] * x1[2]; a[7] += w1[3] * x1[3]; }
#pragma unroll
        for (int e = 0; e < 8; ++e) sxc[tl * XS + c8 + e] = a[e];
        *(LAS u32x4*)(smb + OB_XB + (tl * XBS + c8) * 2) = pack8(a); }
    __syncthreads();
    f32x4 acc[4][4];
    { const bf16x8 a0 = *(const LAS bf16x8*)(smb + OB_XB + ((16 * w + fr) * XBS + 8 * fq) * 2), a1 = *(const LAS bf16x8*)(smb + OB_XB + ((16 * w + fr) * XBS + 32 + 8 * fq) * 2);
#pragma unroll
      for (int g = 0; g < 4; ++g)
#pragma unroll
          for (int cg = 0; cg < 4; ++cg) { const int wb = OB_WT + ((g * 64 + 16 * cg + fr) * XBS + 8 * fq) * 2;
              const bf16x8 b0 = *(const LAS bf16x8*)(smb + wb), b1 = *(const LAS bf16x8*)(smb + wb + 64);
              f32x4 c = {0.f, 0.f, 0.f, 0.f}; c = __builtin_amdgcn_mfma_f32_16x16x32_bf16(a0, b0, c, 0, 0, 0); acc[g][cg] = __builtin_amdgcn_mfma_f32_16x16x32_bf16(a1, b1, c, 0, 0, 0); } }
    float av0[16], uv0[16], av1[16], uv1[16];
    const int run = 4 * w + fq;
    unsigned short ryv[16];
    if (FULL) { const size_t tokb_ = (size_t)b * SEQ + t0 + 16 * w + 4 * fq;
#pragma unroll
        for (int cg = 0; cg < 4; ++cg)
#pragma unroll
            for (int r = 0; r < 4; ++r) ryv[cg * 4 + r] = RYg[(tokb_ + r) * 256 + n * 64 + 16 * cg + fr]; }
#pragma unroll
    for (int cg = 0; cg < 4; ++cg) { const int ch = n * 64 + 16 * cg + fr;
        const float ba0 = ba[ch], ba1 = ba[256 + ch], bx0 = bx[ch], bx1 = bx[256 + ch];
        const float sp0 = log1pf(__expf(-lamp[ch])), sp1 = log1pf(__expf(-lamp[256 + ch]));
        float Af = 1.f, Bf = 0.f, Ab = 1.f, Bb = 0.f;
#pragma unroll
        for (int r = 0; r < 4; ++r) { const float xc = sxc[(16 * w + 4 * fq + r) * XS + 16 * cg + fr];
            { const float rr = sigm(acc[0][cg][r] + ba0), ig = sigm(acc[2][cg][r] + bx0); const float la = -8.f * rr * sp0; av0[cg * 4 + r] = __expf(la); uv0[cg * 4 + r] = __builtin_amdgcn_sqrtf(nexpm1(2.f * la)) * (ig * xc); }
            { const float rr = sigm(acc[1][cg][r] + ba1), ig = sigm(acc[3][cg][r] + bx1); const float la = -8.f * rr * sp1; av1[cg * 4 + r] = __expf(la); uv1[cg * 4 + r] = __builtin_amdgcn_sqrtf(nexpm1(2.f * la)) * (ig * xc); }
            Bf = av0[cg * 4 + r] * Bf + uv0[cg * 4 + r]; Af *= av0[cg * 4 + r]; Bb += Ab * uv1[cg * 4 + r]; Ab *= av1[cg * 4 + r]; }
        sag[((0 * 32 + run) * 64 + 16 * cg + fr) * 2] = Af; sag[((0 * 32 + run) * 64 + 16 * cg + fr) * 2 + 1] = Bf;
        sag[((1 * 32 + run) * 64 + 16 * cg + fr) * 2] = Ab; sag[((1 * 32 + run) * 64 + 16 * cg + fr) * 2 + 1] = Bb; }
    __syncthreads();
    if (tid < 128) { const int dir = tid >> 6, j = tid & 63, ch = n * 64 + j;
        if (!FULL) { float A = 1.f, Bv = 0.f;
            if (dir == 0) { for (int s = 0; s < 32; ++s) { const float a = sag[((0 * 32 + s) * 64 + j) * 2], bb = sag[((0 * 32 + s) * 64 + j) * 2 + 1]; Bv = a * Bv + bb; A *= a; } }
            else { for (int s = 31; s >= 0; --s) { const float a = sag[((1 * 32 + s) * 64 + j) * 2], bb = sag[((1 * 32 + s) * 64 + j) * 2 + 1]; Bv = a * Bv + bb; A *= a; } }
            float* ap = AGG + ((size_t)((b * 2 + dir) * 128 + chunk) * 256 + ch) * 2; ap[0] = A; ap[1] = Bv;
        } else { float hc = CAR[(size_t)((b * 2 + dir) * 128 + chunk) * 256 + ch];
            if (dir == 0) { for (int s = 0; s < 32; ++s) { const int ix = ((0 * 32 + s) * 64 + j) * 2; const float a = sag[ix], bb = sag[ix + 1]; sag[ix] = hc; hc = a * hc + bb; } }
            else { for (int s = 31; s >= 0; --s) { const int ix = ((1 * 32 + s) * 64 + j) * 2; const float a = sag[ix], bb = sag[ix + 1]; sag[ix] = hc; hc = a * hc + bb; } } } }
    if (FULL) {
        __syncthreads();
        const size_t tokb = (size_t)b * SEQ + t0 + 16 * w + 4 * fq;
#pragma unroll
        for (int cg = 0; cg < 4; ++cg) { const int ch = n * 64 + 16 * cg + fr;
            float hf = sag[((0 * 32 + run) * 64 + 16 * cg + fr) * 2], hb = sag[((1 * 32 + run) * 64 + 16 * cg + fr) * 2]; float hs[4];
#pragma unroll
            for (int r = 0; r < 4; ++r) { hf = av0[cg * 4 + r] * hf + uv0[cg * 4 + r]; hs[r] = hf; }
#pragma unroll
            for (int r = 3; r >= 0; --r) { hb = av1[cg * 4 + r] * hb + uv1[cg * 4 + r]; hs[r] += hb; }
#pragma unroll
            for (int r = 0; r < 4; ++r) { const float y = bf2f(ryv[cg * 4 + r]); MIX[(tokb + r) * 1024 + 256 + ch] = (bf16_t)f2bf(hs[r] * y); } }
    }
    __syncthreads();
}
template <bool FULL>
__device__ __forceinline__ void phase_rg(LAS unsigned char* smb, int blk, int G, const float* RX, const bf16_t* RYg, const float* cw, const float* cb, const bf16_t* RGW, const float* ba, const float* bx,
                                         const float* lamp, float* AGG, const float* CAR, bf16_t* MIX) {
    const int tid = ltid(); int u = blk; if (u >= 1024) return;
    PreR pre = issue_r(u, RX, tid);
#pragma unroll 1
    for (; u < 1024; u += G) { PreR nxt = pre; if (u + G < 1024) nxt = issue_r(u + G, RX, tid);
        unit_pre<FULL>(smb, u, pre, tid, RYg, cw, cb, RGW, ba, bx, lamp, AGG, CAR, MIX); pre = nxt; }
}
}

template <int MODE>
__device__ __forceinline__ void p0_transpose_item(const float* W, int K, int N, bf16_t* WT, LAS float* scr, int item, int lane) {
    const int nblk = N / 32, kb = item / nblk, nb = item % nblk, k0 = 64 * kb, n0 = 32 * nb;
#pragma unroll 16
    for (int i = 0; i < 32; ++i) { const int kk = 2 * i + (lane >> 5); scr[kk * 33 + (lane & 31)] = W[(size_t)(k0 + kk) * N + n0 + (lane & 31)]; }
    asm volatile("s_waitcnt lgkmcnt(0)" ::: "memory");
    const int c = lane & 7;
#pragma unroll
    for (int jx = 0; jx < 4; ++jx) { const int n = (lane >> 3) + 8 * jx; const LAS float* s = scr + (8 * c) * 33 + n;
        u32x4 o; o.x = pk2(s[0 * 33], s[1 * 33]); o.y = pk2(s[2 * 33], s[3 * 33]); o.z = pk2(s[4 * 33], s[5 * 33]); o.w = pk2(s[6 * 33], s[7 * 33]);
        int nr = n0 + n;
        if (MODE == 1) { if (nr >= 1792 && nr < 2816) { const int l = nr & 63; nr = (nr & ~63) + ((l & 31) << 1) + (l >> 5); } }
        if (MODE == 2) { if (nr < DFF) nr = ((nr >> 7) << 8) + (nr & 127); else { const int cc = nr - DFF; nr = ((cc >> 7) << 8) + 128 + (cc & 127); } }
        *(u32x4*)(WT + (size_t)nr * K + k0 + 8 * c) = o; }
    asm volatile("s_waitcnt lgkmcnt(0)" ::: "memory");
}

#define XB_TMO      128
#define XB_XCNT(j)  (256  + 64 * (j))
#define XB_XSUB(j)  (1280 + 64 * (j))
#define XB_XGEN(j)  (2304 + 64 * (j))
#define XB_TOP      3328
#define XB_TOPGEN   3392
#define XCD_BAR_WORDS 3456
#define XB_SPIN_CAP (1u << 18)

__device__ __forceinline__ unsigned xb_ld(unsigned* p)              { return __hip_atomic_load(p, __ATOMIC_RELAXED, __HIP_MEMORY_SCOPE_AGENT); }
__device__ __forceinline__ unsigned xb_add(unsigned* p, unsigned v) { return __hip_atomic_fetch_add(p, v, __ATOMIC_RELAXED, __HIP_MEMORY_SCOPE_AGENT); }
__device__ __forceinline__ unsigned xb_xcc_id() { return (unsigned)__builtin_amdgcn_s_getreg((3 << 11) | 20) & 0xFu; }
#define XB_SPIN(cond, bar) do { unsigned _sp = 0; while (cond) { __builtin_amdgcn_s_sleep(1); \
    if ((++_sp & 255u) == 0u) { if (xb_ld(&(bar)[XB_TMO])) break; if (_sp > XB_SPIN_CAP) { atomicAdd(&(bar)[XB_TMO], 1u); break; } } } } while (0)

struct XcdBarrier {
    unsigned* bar; unsigned x;
    volatile LAS unsigned* st;
};

__device__ __forceinline__ XcdBarrier xcd_barrier_post(unsigned* bar, volatile LAS unsigned* st) {
    XcdBarrier b; b.bar = bar; b.x = xb_xcc_id(); b.st = st;
    if (threadIdx.x == 0) (void)xb_add(&bar[XB_XCNT(b.x)], 1u);
    return b;
}
__device__ __forceinline__ void xcd_barrier_complete(unsigned* bar, unsigned x, unsigned& nloc, unsigned& nx) {
    const unsigned G = gridDim.x * gridDim.y * gridDim.z;
    unsigned sum, cnt, mine, sp = 0u;
    for (;;) {
        sum = 0u; cnt = 0u; mine = 0u;
#pragma unroll
        for (unsigned j = 0; j < 16; ++j) { const unsigned c = xb_ld(&bar[XB_XCNT(j)]); sum += c; cnt += (c > 0u) ? 1u : 0u; mine = (j == x) ? c : mine; }
        if (sum == G) break;
        __builtin_amdgcn_s_sleep(1);
        if ((++sp & 255u) == 0u) { if (xb_ld(&bar[XB_TMO])) break; if (sp > XB_SPIN_CAP) { atomicAdd(&bar[XB_TMO], 1u); break; } }
    }
    nloc = mine > 0u ? mine : 1u; nx = cnt > 0u ? cnt : 1u;
}

__device__ __forceinline__ void xcd_barrier(const XcdBarrier& b) {
    asm volatile("s_waitcnt vmcnt(0)" ::: "memory");
    __syncthreads();
    if (threadIdx.x == 0) {
        unsigned* bar = b.bar;
        __builtin_amdgcn_s_waitcnt(0);
        unsigned nloc = b.st[0], nx = b.st[1];
        if (nloc == 0u) { xcd_barrier_complete(bar, b.x, nloc, nx); b.st[0] = nloc; b.st[1] = nx; }
        const unsigned old = xb_add(&bar[XB_XSUB(b.x)], 1u);
        const unsigned gen = old / nloc;
        if (old + 1u == (gen + 1u) * nloc) {
            __builtin_amdgcn_fence(__ATOMIC_RELEASE, "agent");
            asm volatile("s_waitcnt vmcnt(0)" ::: "memory");
            const unsigned og = xb_add(&bar[XB_TOP], 1u);
            const unsigned tg = og / nx;
            if (og + 1u == (tg + 1u) * nx) xb_add(&bar[XB_TOPGEN], 1u);
            else XB_SPIN(xb_ld(&bar[XB_TOPGEN]) == tg, bar);
            __builtin_amdgcn_fence(__ATOMIC_ACQUIRE, "agent");
            xb_add(&bar[XB_XGEN(b.x)], 1u);
            asm volatile("s_waitcnt vmcnt(0)" ::: "memory");
        } else {
            XB_SPIN(xb_ld(&bar[XB_XGEN(b.x)]) == gen, bar);
            __builtin_amdgcn_fence(__ATOMIC_ACQUIRE, "agent");
            asm volatile("s_waitcnt vmcnt(0)" ::: "memory");
        }
    }
    __syncthreads();
}


#define GAS __attribute__((address_space(1)))
#define WSL() ({ GAS unsigned char* w_ = (GAS unsigned char*)p.ws; asm volatile("" : "+s"(w_)); (unsigned char*)w_; })
#define INP(k) ({ int k_ = (k); asm volatile("" : "+s"(k_)); (const float*)(const GAS float*)p.in[k_]; })
#define POUT() ((float*)(GAS float*)p.out)
#define LN_PASS(GI, BI, WRITE_X) do { IDS(); unsigned char* ws_ = WSL(); float* X_ = POUT(); bf16_t* XN_ = (bf16_t*)(ws_ + A_XN); float* ST_ = (float*)(ws_ + WS_STATS); const float* gg = INP(GI) + layer * DM; const float* bb = INP(BI) + layer * DM; \
        f32x4 gvv[4], bvv[4];   \
        _Pragma("unroll") for (int jx = 0; jx < 4; ++jx) { gvv[jx] = *(const f32x4*)(gg + jx * 256 + lane * 4); bvv[jx] = *(const f32x4*)(bb + jx * 256 + lane * 4); } \
        for (int m_ = bx * 16 + wave * 2; m_ < M; m_ += G * 16) {   \
            f32x4 v[2][4]; float s[2] = {0.f, 0.f}; \
            _Pragma("unroll") for (int q = 0; q < 2; ++q) _Pragma("unroll") for (int jx = 0; jx < 4; ++jx) v[q][jx] = *(const f32x4*)(X_ + (size_t)(m_ + q) * DM + jx * 256 + lane * 4); \
            _Pragma("unroll") for (int q = 0; q < 2; ++q) { const int m = m_ + q; float* xr = X_ + (size_t)m * DM; \
            _Pragma("unroll") for (int jx = 0; jx < 4; ++jx) s[q] += (v[q][jx][0] + v[q][jx][1]) + (v[q][jx][2] + v[q][jx][3]); \
            s[q] = sum64(s[q]); \
            const float mean = s[q] * (1.f / DM); float s2 = 0.f; \
            _Pragma("unroll") for (int jx = 0; jx < 4; ++jx) { v[q][jx] = v[q][jx] - mean; s2 += (v[q][jx][0] * v[q][jx][0] + v[q][jx][1] * v[q][jx][1]) + (v[q][jx][2] * v[q][jx][2] + v[q][jx][3] * v[q][jx][3]); } \
            s2 = sum64(s2); \
            const float rstd = rsqrtf(s2 * (1.f / DM) + 1e-5f); \
            if (lane == 0) { ST_[(size_t)m * 2] = mean; ST_[(size_t)m * 2 + 1] = rstd; } \
            _Pragma("unroll") for (int jx = 0; jx < 4; ++jx) { const f32x4 gv = gvv[jx], bv = bvv[jx]; \
                const f32x4 y = v[q][jx] * rstd * gv + bv; if (WRITE_X) *(f32x4*)(xr + jx * 256 + lane * 4) = y; \
                if (!(WRITE_X)) { u32x2 w; w.x = pk2(y[0], y[1]); w.y = pk2(y[2], y[3]); *(u32x2*)(XN_ + (size_t)m * DM + jx * 256 + lane * 4) = w; } } } } } while (0)

__global__ void __launch_bounds__(512, 2) fwd_megakernel(Params p) {
    extern __shared__ __attribute__((aligned(16))) unsigned char lds_raw[];
    cg::grid_group grid = cg::this_grid();
    LAS unsigned char* lds = (LAS unsigned char*)lds_raw;
    LAS float* smf = (LAS float*)lds_raw;
    volatile LAS unsigned* bst = (volatile LAS unsigned*)(lds + 131072 + 512);
    if (threadIdx.x < 2) bst[threadIdx.x] = 0u;
    __syncthreads();
    (void)xcd_barrier_post((unsigned*)((unsigned char*)(GAS unsigned char*)p.ws + WS_SMALL + 65536), bst);
#define GSYNC() do { XcdBarrier xb_; xb_.bar = (unsigned*)(WSL() + WS_SMALL + 65536); xb_.x = xb_xcc_id(); xb_.st = (volatile LAS unsigned*)(lds + 131072 + 512); xcd_barrier(xb_); } while (0)
#define IDS() const int tid = ltid(), lane = tid & 63, wave = tid >> 6, bx = lbid(), G = lgdim(); (void)lane; (void)wave; (void)bx; (void)G; (void)tid

    if (PH(0)) {
        IDS(); unsigned char* ws = WSL();
        const float* x_in = (const float*)(const GAS float*)p.in[0];
        bf16_t* XN = (bf16_t*)(ws + A_XN);
        float* COS = (float*)(ws + WS_COS); float* SIN = (float*)(ws + WS_SIN);
        float* LBT = (float*)(ws + WS_SMALL); float* LAMV = (float*)(ws + WS_SMALL + 8192);
        LAS float* scr = smf + wave * (64 * 33);
        const int gw = bx * 8 + wave, NGW = G * 8;
        constexpr int I_IN = 16 * (DIN / 32), I_SQ = 16 * 32, I_UP = 16 * (2 * DFF / 32), I_DN = (DFF / 64) * 32, I_L = I_IN + 4 * I_SQ + I_UP + I_DN;
        for (int it = gw; it < 2 * I_L; it += NGW) {
            const int l = it / I_L; int r = it % I_L; bf16_t* wl = (bf16_t*)(ws + WS_W + (size_t)l * W_LAYER);
            if (r < I_IN) { p0_transpose_item<1>((const float*)(const GAS float*)p.in[3] + (size_t)l * DM * DIN, DM, DIN, (bf16_t*)((char*)wl + W_IN), scr, r, lane); continue; } r -= I_IN;
            if (r < I_SQ) { p0_transpose_item<0>((const float*)(const GAS float*)p.in[15] + (size_t)l * DM * DM, DM, DM, (bf16_t*)((char*)wl + W_OUT), scr, r, lane); continue; } r -= I_SQ;
            if (r < I_SQ) { p0_transpose_item<0>((const float*)(const GAS float*)p.in[19] + (size_t)l * DM * DM, DM, DM, (bf16_t*)((char*)wl + W_K), scr, r, lane); continue; } r -= I_SQ;
            if (r < I_SQ) { p0_transpose_item<0>((const float*)(const GAS float*)p.in[20] + (size_t)l * DM * DM, DM, DM, (bf16_t*)((char*)wl + W_V), scr, r, lane); continue; } r -= I_SQ;
            if (r < I_SQ) { p0_transpose_item<0>((const float*)(const GAS float*)p.in[21] + (size_t)l * DM * DM, DM, DM, (bf16_t*)((char*)wl + W_O), scr, r, lane); continue; } r -= I_SQ;
            if (r < I_UP) { p0_transpose_item<2>((const float*)(const GAS float*)p.in[24] + (size_t)l * DM * 2 * DFF, DM, 2 * DFF, (bf16_t*)((char*)wl + W_UP), scr, r, lane); continue; } r -= I_UP;
            p0_transpose_item<0>((const float*)(const GAS float*)p.in[27] + (size_t)l * DFF * DM, DFF, DM, (bf16_t*)((char*)wl + W_DN), scr, r, lane);
        }
        const size_t gt = (size_t)bx * 512 + tid, NT = (size_t)G * 512;
        for (size_t i = gt; i < (size_t)M * DM / 8; i += 4 * NT) { f32x4 a[4], b[4];
#pragma unroll
            for (int q = 0; q < 4; ++q) { a[q] = *(const f32x4*)(x_in + (i + q * NT) * 8); b[q] = *(const f32x4*)(x_in + (i + q * NT) * 8 + 4); }
#pragma unroll
            for (int q = 0; q < 4; ++q) { u32x4 w; w.x = pk2(a[q][0], a[q][1]); w.y = pk2(a[q][2], a[q][3]); w.z = pk2(b[q][0], b[q][1]); w.w = pk2(b[q][2], b[q][3]); *(u32x4*)(XN + (i + q * NT) * 8) = w; } }
        { const float* mem = (const float*)(const GAS float*)p.in[1]; bf16_t* MEMB = (bf16_t*)(ws + A_MEMB);
          for (size_t i = gt; i < (size_t)BATCH * NMEM * DM / 8; i += NT) { const f32x4 a = *(const f32x4*)(mem + i * 8), b = *(const f32x4*)(mem + i * 8 + 4);
              u32x4 w; w.x = pk2(a[0], a[1]); w.y = pk2(a[2], a[3]); w.z = pk2(b[0], b[1]); w.w = pk2(b[2], b[3]); *(u32x4*)(MEMB + i * 8) = w; } }
        for (size_t i = gt; i < (size_t)2 * DM * DM / 8; i += NT) { const int l = (int)(i / (DM * DM / 8)); const size_t r = i % (DM * DM / 8);
            const float* src = (const float*)(const GAS float*)p.in[18] + (size_t)l * DM * DM + r * 8; bf16_t* dst = (bf16_t*)(ws + WS_W + (size_t)l * W_LAYER + W_Q) + r * 8;
            const f32x4 a = *(const f32x4*)src, b = *(const f32x4*)(src + 4);
            u32x4 w; w.x = pk2(a[0], a[1]); w.y = pk2(a[2], a[3]); w.z = pk2(b[0], b[1]); w.w = pk2(b[2], b[3]); *(u32x4*)dst = w; }
        { const int* pos = (const int*)(const GAS int*)p.in[2];
          for (size_t i = gt; i < (size_t)M * 32; i += NT) { const int tok = (int)(i >> 5), fi = (int)(i & 31);
              const double inv = exp(-(double)fi * (9.210340371976184 / 32.0)); const double ang = (double)pos[tok] * inv;
              const double k = rint(ang * 0.15915494309189535); double r = fma(-k, 6.283185307179586, ang); r = fma(-k, 2.4492935982947064e-16, r);
              const float rf = (float)r; COS[i] = cosf(rf); SIN[i] = sinf(rf); } }
        { bf16_t* RGW = (bf16_t*)(ws + WS_RGW); const float* wa = (const float*)(const GAS float*)p.in[8]; const float* wx = (const float*)(const GAS float*)p.in[10];
          for (size_t i = gt; i < (size_t)2 * 4 * 4 * 4096; i += NT) { const int ii = (int)(i & 63), jj = (int)((i >> 6) & 63), g = (int)((i >> 12) & 3), n = (int)((i >> 14) & 3), l = (int)(i >> 16);
              const float* src = (g < 2 ? wa : wx) + ((size_t)((l * 2 + (g & 1)) * 4 + n)) * 4096 + ii * 64 + jj; RGW[i] = (bf16_t)f2bf(*src); } }
        if (bx == 0) {
            const float* hlb = (const float*)(const GAS float*)p.in[4];
            for (int i = tid; i < 512; i += 512) { const float e0 = __expf(hlb[i]), e1 = __expf(hlb[512 + i]); LBT[i] = 0.f; LBT[512 + i] = e1 / (e0 + e1); }
            if (tid < 2) { const float* lp = (const float*)(const GAS float*)p.in[13] + tid * 256; float s1 = 0.f, s2 = 0.f; for (int k = 0; k < 64; ++k) { s1 += lp[k] * lp[64 + k]; s2 += lp[128 + k] * lp[192 + k]; }
                LAMV[tid] = expf(s1) - expf(s2) + (0.8f - 0.6f * expf(-0.3f * (float)tid)); }
        }
    }
    grid.sync();
    if (PH(1) && lbid() < 32) {
        IDS(); unsigned char* ws = WSL();
        const int ci = bx >> 3, l = ci >> 1, kv = ci & 1;
        pg8::Gemm g{(const bf16_t*)(ws + A_MEMB), (const bf16_t*)(ws + WS_W + (size_t)l * W_LAYER + (kv ? W_V : W_K)), 512, DM, DM, DM, DM, 1 << 30, 0};
        pg8::StaticOrder S; S.init(512, DM, 8, bx & 7);
        pg8::EpiRow8<FStore> E{{(bf16_t*)(ws + (kv ? A_VMEM : A_KMEM) + (size_t)l * MiB), DM}};
        pg8::gemm_phase(lds, g, S, E);
    }
    GSYNC();
    if (PH(2) && lbid() < 128) {
        IDS(); unsigned char* ws = WSL();
        const int ci = bx >> 2, which = ci >> 4, l = (ci >> 3) & 1, b = (ci >> 2) & 1, h = ci & 3;
        const bf16_t* wl = (const bf16_t*)(ws + WS_W + (size_t)l * W_LAYER);
        pg8::Gemm g; pg8::StaticOrder S; bf16_t* O;
        if (which == 0) {
            g = pg8::Gemm{(const bf16_t*)(ws + A_KMEM + (size_t)l * MiB) + (size_t)b * 256 * DM + h * 256, (const bf16_t*)((const char*)wl + W_Q) + h * 256, 256, DM, 256, DM, DM, 1 << 30, 0};
            S.init(256, DM, 4, bx & 3);
            O = (bf16_t*)(ws + WS_GB) + ((size_t)(l * 2 + b) * DM + h * 256) * DM;
        } else {
            g = pg8::Gemm{(const bf16_t*)((const char*)wl + W_O) + h * 256, (const bf16_t*)(ws + A_VMEM + (size_t)l * MiB) + (size_t)b * 256 * DM + h * 256, DM, 256, 256, DM, DM, 1 << 30, 0};
            S.init(DM, 256, 4, bx & 3);
            O = (bf16_t*)(ws + WS_BT2) + (size_t)(l * 2 + b) * DM * DM + h * 256;
        }
        pg8::EpiRow8<FStore> E{{O, DM}};
        pg8::gemm_phase(lds, g, S, E);
    }
    GSYNC();

#pragma unroll 1
    for (int layer = 0; layer < DEPTH; ++layer) {
        _Pragma("unroll 1") for (int rep_ = REPS(3); rep_ > 0; --rep_) if (PH(3)) {
            IDS(); unsigned char* ws = WSL();
            pg8::Gemm g{(const bf16_t*)(ws + A_XN), (const bf16_t*)(ws + WS_W + (size_t)layer * W_LAYER + W_IN), M, DIN, DM, DM, DM, 1 << 30, 0};
            pg8::StaticOrder S; S.init(M, DIN, G, bx);
            pg8::EpiRow8<FProj> E{{(bf16_t*)(ws + A_HQ), (bf16_t*)(ws + A_HI), (bf16_t*)(ws + A_HG), (bf16_t*)(ws + A_RY), (bf16_t*)(ws + A_DQ), (bf16_t*)(ws + A_DK), (bf16_t*)(ws + A_DV),
                                   (float*)(ws + A_ZF0), (float*)(ws + A_ZF1), (float*)(ws + A_RX), (const float*)(ws + WS_COS), (const float*)(ws + WS_SIN)}};
            pg8::gemm_phase(lds, g, S, E);
        }
        GSYNC();
        if (PH(4)) {
            IDS();
            { unsigned char* ws = WSL(); const float* lbt = (const float*)(ws + WS_SMALL) + layer * 512;
              _Pragma("unroll 1") for (int rep_ = REPS(4); rep_ > 0; --rep_) hg::phase_a(smf, bx, G, (const float*)(ws + A_ZF0), (const float*)(ws + A_ZF1), (const bf16_t*)(ws + A_HI), lbt, (float*)(ws + A_ST), (float*)(ws + A_HD)); }
            { unsigned char* ws = WSL();
              _Pragma("unroll 1") for (int rep_ = REPS(12); rep_ > 0; --rep_) rg::phase_rg<false>(lds, bx, G, (const float*)(ws + A_RX), (const bf16_t*)(ws + A_RY), INP(6) + layer * 1024, INP(7) + layer * 256, (const bf16_t*)(ws + WS_RGW) + (size_t)layer * 65536, INP(9) + layer * 512,
                                INP(11) + layer * 512, INP(12) + layer * 512, (float*)(ws + A_RGAGG), (const float*)(ws + A_RGCAR), (bf16_t*)(ws + A_XN)); }
        }
        GSYNC();
        { IDS(); unsigned char* ws = WSL();
          hg::phase_b((float*)(ws + A_ST), (const float*)(ws + A_HD));
          if (bx >= 128 && bx < 130) {
            const float* AGG = (const float*)(ws + A_RGAGG); float* CAR = (float*)(ws + A_RGCAR);
            const int gid = (bx - 128) * 512 + tid; const int ch = gid & 255, dir = (gid >> 8) & 1, b = gid >> 9;
            const size_t base = (size_t)((b * 2 + dir) * 128) * 256 + ch; float h = 0.f;
            typedef float f32x2 __attribute__((ext_vector_type(2)));
#pragma unroll 1
            for (int q0 = 0; q0 < 128; q0 += 16) { f32x2 ab[16];
#pragma unroll
                for (int i = 0; i < 16; ++i) { const int c = dir ? 127 - (q0 + i) : q0 + i; ab[i] = *(const f32x2*)(AGG + (base + (size_t)c * 256) * 2); }
#pragma unroll
                for (int i = 0; i < 16; ++i) { const int c = dir ? 127 - (q0 + i) : q0 + i; CAR[base + (size_t)c * 256] = h; h = ab[i][0] * h + ab[i][1]; } }
          } }
        GSYNC();
        if (PH(5)) {
            IDS();
            { unsigned char* ws = WSL(); const float* lbt = (const float*)(ws + WS_SMALL) + layer * 512;
              _Pragma("unroll 1") for (int rep_ = REPS(5); rep_ > 0; --rep_) hg::phase_c(smf, bx, G, (const float*)(ws + A_ZF0), (const float*)(ws + A_ZF1), (const bf16_t*)(ws + A_HQ), (const bf16_t*)(ws + A_HI), (const bf16_t*)(ws + A_HG), lbt,
                                                            (const float*)(ws + A_ST), INP(5) + layer * 256, (bf16_t*)(ws + A_XN)); }
            { unsigned char* ws = WSL();
              _Pragma("unroll 1") for (int rep_ = REPS(13); rep_ > 0; --rep_) rg::phase_rg<true>(lds, bx, G, (const float*)(ws + A_RX), (const bf16_t*)(ws + A_RY), INP(6) + layer * 1024, INP(7) + layer * 256, (const bf16_t*)(ws + WS_RGW) + (size_t)layer * 65536, INP(9) + layer * 512,
                               INP(11) + layer * 512, INP(12) + layer * 512, (float*)(ws + A_RGAGG), (const float*)(ws + A_RGCAR), (bf16_t*)(ws + A_XN)); }
        }
        _Pragma("unroll 1") for (int rep_ = REPS(6); rep_ > 0; --rep_) if (PH(6)) {
            IDS(); unsigned char* ws = WSL();
            const bf16_t* DQ = (const bf16_t*)(ws + A_DQ); const bf16_t* DK = (const bf16_t*)(ws + A_DK); const bf16_t* DV = (const bf16_t*)(ws + A_DV); bf16_t* MIX = (bf16_t*)(ws + A_XN);
            const float lam = ((const float*)(ws + WS_SMALL + 8192))[layer]; const float gscale = 1.f - (0.8f - 0.6f * expf(-0.3f * (float)layer));
            float* scratch = (float*)(ws + A_MIX_END) + (size_t)bx * 256 * 128;
            const float* subg = INP(14) + layer * 128;
            const int vcu = (G % 8 == 0) ? (bx % 8) * (G / 8) + bx / 8 : bx;
            for (int pr = vcu; pr < 512; pr += G) {
                const int bh = pr >> 6, qb = pr & 63, b = bh >> 2, h = bh & 3;
                const size_t row0 = (size_t)b * SEQ;
#pragma unroll 1
                for (int c = 0; c < 2; ++c) {
                    att::attn_unit(DQ + (row0 + qb * 256) * 512 + (h * 2 + c) * 64, DK + row0 * 512 + (h * 2 + c) * 64, DV + row0 * 512 + h * 128, SEQ, (char*)lds_raw,
                                   c, scratch, lam, gscale, subg, MIX + (row0 + qb * 256) * 1024 + 512 + h * 128);
                }
            }
        }
        GSYNC();
        if (PH(7)) {
            IDS(); unsigned char* ws = WSL();
            pg8::Gemm g{(const bf16_t*)(ws + A_XN), (const bf16_t*)(ws + WS_W + (size_t)layer * W_LAYER + W_OUT), M, DM, DM, DM, DM, 1 << 30, 0};
            pg8::StaticOrder S; S.init(M, DM, G, bx);
            EpiRes E{(layer == 0) ? (const float*)(const GAS float*)p.in[0] : (const float*)POUT(), POUT(), (layer == 0) ? (const float*)nullptr : (const float*)(ws + WS_STATS), INP(28) + (layer - 1) * DM, INP(29) + (layer - 1) * DM};
            pg8::gemm_phase(lds, g, S, E);
        }
        GSYNC();
        LN_PASS(16, 17, false);
        GSYNC();
        _Pragma("unroll 1") for (int rep_ = REPS(8); rep_ > 0; --rep_) if (PH(8)) {
            IDS(); unsigned char* ws = WSL();
            pg8::Gemm g{(const bf16_t*)(ws + A_XN), (const bf16_t*)(ws + WS_GB) + (size_t)layer * 2 * DM * DM, M, DM, DM, DM, DM, 64, (size_t)DM * DM};
            pg8::StaticOrder S; S.init(M, DM, G, bx);
            pg8::EpiRow8<FScores> E{{(bf16_t*)(ws + A_P), (float*)(ws + A_LSUM)}};
            pg8::gemm_phase(lds, g, S, E);
        }
        GSYNC();
        { IDS(); unsigned char* ws = WSL(); bf16_t* PB = (bf16_t*)(ws + A_P); const float* LS = (const float*)(ws + A_LSUM);
          const size_t NTH = (size_t)G * 512;
          for (size_t i0 = (size_t)bx * 512 + tid; i0 < (size_t)M * DM / 8; i0 += 2 * NTH) {
            f32x4 a[2], b[2]; u32x4 pw[2];
#pragma unroll
            for (int q = 0; q < 2; ++q) { const size_t i = i0 + q * NTH; const size_t row = i >> 7; const int c8 = (int)(i & 127) * 8, hd = c8 >> 8; const float* lp = LS + row * 32 + hd * 8;
                a[q] = *(const f32x4*)lp; b[q] = *(const f32x4*)(lp + 4); pw[q] = *(const u32x4*)(PB + i * 8); }
#pragma unroll
            for (int q = 0; q < 2; ++q) { const size_t i = i0 + q * NTH; const float inv = __builtin_amdgcn_rcpf(((a[q][0] + a[q][1]) + (a[q][2] + a[q][3])) + ((b[q][0] + b[q][1]) + (b[q][2] + b[q][3])));
                float v[8]; unpack8(pw[q], v);
#pragma unroll
                for (int e = 0; e < 8; ++e) v[e] *= inv;
                st8_bf16(PB + i * 8, v); }
          } }
        GSYNC();
        if (PH(9)) {
            IDS(); unsigned char* ws = WSL();
            pg8::Gemm g{(const bf16_t*)(ws + A_P), (const bf16_t*)(ws + WS_BT2) + (size_t)layer * 2 * DM * DM, M, DM, DM, DM, DM, 64, (size_t)DM * DM};
            pg8::StaticOrder S; S.init(M, DM, G, bx);
            EpiRes E{(const float*)POUT(), POUT(), (const float*)(ws + WS_STATS), INP(16) + layer * DM, INP(17) + layer * DM};
            pg8::gemm_phase(lds, g, S, E);
        }
        GSYNC();
        LN_PASS(22, 23, false);
        GSYNC();
        _Pragma("unroll 1") for (int rep_ = REPS(10); rep_ > 0; --rep_) if (PH(10)) {
            IDS(); unsigned char* ws = WSL();
            pg8::Gemm g{(const bf16_t*)(ws + A_XN), (const bf16_t*)(ws + WS_W + (size_t)layer * W_LAYER + W_UP), M, 2 * DFF, DM, DM, DM, 1 << 30, 0};
            pg8::StaticOrder S; S.init(M, 2 * DFF, G, bx);
            EpiUpConv E{(bf16_t*)(ws + A_VAL), (float*)(ws + A_GATE), INP(25) + (size_t)layer * 3 * DFF, INP(26) + (size_t)layer * DFF};
            pg8::gemm_phase<EpiUpConv, true>(lds, g, S, E);
        }
        GSYNC();
        {
            IDS(); unsigned char* ws = WSL(); bf16_t* H = (bf16_t*)(ws + A_VAL); const float* SB = (const float*)(ws + A_GATE);
            const float* cw = INP(25) + (size_t)layer * 3 * DFF;
            const size_t PL_ = 256 * (size_t)DFF;
            for (size_t i = (size_t)bx * 512 + tid; i < (size_t)2 * 256 * DFF; i += (size_t)G * 512) {
                const int side = (int)(i / (256 * (size_t)DFF)); const size_t r = i % (256 * (size_t)DFF); const int grp = (int)(r / DFF), c = (int)(r % DFF);
                float part, val, nb; size_t tok;
                if (side == 0) { part = SB[0 * PL_ + r]; val = SB[1 * PL_ + r]; nb = ((grp & 127) == 0) ? 0.f : SB[5 * PL_ + (size_t)(grp - 1) * DFF + c]; part += cw[c] * nb; tok = (size_t)grp * 128; }
                else { part = SB[3 * PL_ + r]; val = SB[4 * PL_ + r]; nb = ((grp & 127) == 127) ? 0.f : SB[2 * PL_ + (size_t)(grp + 1) * DFF + c]; part += cw[2 * DFF + c] * nb; tok = (size_t)grp * 128 + 127; }
                H[tok * DFF + c] = (bf16_t)f2bf(gelu_tanh(part) * val);
            }
        }
        GSYNC();
        if (PH(11)) {
            IDS(); unsigned char* ws = WSL();
            pg8::Gemm g{(const bf16_t*)(ws + A_VAL), (const bf16_t*)(ws + WS_W + (size_t)layer * W_LAYER + W_DN), M, DM, DFF, DFF, DFF, 1 << 30, 0};
            pg8::StaticOrder S; S.init(M, DM, G, bx);
            EpiRes E{(const float*)POUT(), POUT(), (const float*)(ws + WS_STATS), INP(22) + layer * DM, INP(23) + layer * DM};
            pg8::gemm_phase(lds, g, S, E);
        }
        GSYNC();
        LN_PASS(28, 29, (layer == DEPTH - 1));
        GSYNC();
    }
}

extern "C" void kernel_launch(void* const* d_in, const int* in_sizes, int n_in, void* d_out, int out_size, void* d_ws, size_t ws_size, hipStream_t stream) {
    static int grid_blocks = 0;
    if (grid_blocks == 0) {
        if (n_in != 30 || out_size != M * DM || ws_size < WS_END) { fprintf(stderr, "kernel_launch: unexpected shapes (n_in %d out %d ws %zu, need ws >= %zu)\n", n_in, out_size, ws_size, (size_t)WS_END); grid_blocks = -1; return; }
        int dev = 0, cus = 0, per_cu = 0;
        hipGetDevice(&dev); hipDeviceGetAttribute(&cus, hipDeviceAttributeMultiprocessorCount, dev);
        if (hipFuncSetAttribute((const void*)fwd_megakernel, hipFuncAttributeMaxDynamicSharedMemorySize, LDS_BYTES) != hipSuccess) { fprintf(stderr, "kernel_launch: hipFuncSetAttribute failed\n"); grid_blocks = -1; return; }
        hipOccupancyMaxActiveBlocksPerMultiprocessor(&per_cu, (const void*)fwd_megakernel, 512, LDS_BYTES);
        if (per_cu < 1) { fprintf(stderr, "kernel_launch: occupancy query says %d\n", per_cu); per_cu = 1; }
        grid_blocks = cus * 1;
        (void)hipGetLastError();
    }
    if (grid_blocks < 0) return;
    if (hipMemsetAsync((char*)d_ws + WS_SMALL + 65536, 0, 16384, stream) != hipSuccess) { fprintf(stderr, "kernel_launch: memset failed\n"); return; }
    Params p{};
    for (int i = 0; i < 30; ++i) p.in[i] = d_in[i];
    p.out = (float*)d_out; p.ws = (unsigned char*)d_ws;
    void* args[] = {&p};
    hipError_t e = hipLaunchCooperativeKernel((const void*)fwd_megakernel, dim3(grid_blocks), dim3(512), args, LDS_BYTES, stream);
    if (e != hipSuccess) fprintf(stderr, "cooperative launch failed: %s (grid %d)\n", hipGetErrorString(e), grid_blocks);
}
```

```cpp
#include <hip/hip_runtime.h>
#include <hip/hip_cooperative_groups.h>
#include <cstdio>
#include <cstdint>
namespace cg = cooperative_groups;

#define LAS __attribute__((address_space(3)))
typedef unsigned short bf16_t;
typedef short bf16x8 __attribute__((ext_vector_type(8)));
typedef short s16x4 __attribute__((ext_vector_type(4)));
typedef float f32x4 __attribute__((ext_vector_type(4)));
typedef float f32x16 __attribute__((ext_vector_type(16)));
typedef unsigned u32x4 __attribute__((ext_vector_type(4)));
typedef unsigned u32x2 __attribute__((ext_vector_type(2)));

constexpr int BATCH = 2, SEQ = 16384, DM = 1024, DEPTH = 2, M = BATCH * SEQ, DIN = 3328, DFF = 2816, NMEM = 256;
constexpr float ALPHA = 1.4142135623730951f;
constexpr size_t MiB = 1u << 20;
constexpr size_t WS_COS = 0, WS_SIN = 4 * MiB, WS_SMALL = 8 * MiB;
constexpr size_t WS_RGW = 8 * MiB + 131072;
constexpr size_t WS_STATS = 8 * MiB + 524288;
constexpr size_t WS_GB = 9 * MiB;
constexpr size_t WS_BT2 = 17 * MiB;
constexpr size_t WS_W = 25 * MiB;
constexpr size_t W_IN = 0, W_OUT = 13 * MiB / 2, W_Q = W_OUT + 2 * MiB, W_K = W_Q + 2 * MiB, W_V = W_K + 2 * MiB, W_O = W_V + 2 * MiB, W_UP = W_O + 2 * MiB, W_DN = W_UP + 11 * MiB, W_LAYER = W_DN + 11 * MiB / 2;
static_assert(W_LAYER == 33 * MiB && WS_W + 2 * W_LAYER <= 92 * MiB, "weights per layer");
constexpr size_t WS_ARENA = 92 * MiB;
constexpr size_t A_XN = WS_ARENA;
constexpr size_t A_HQ = WS_ARENA + 64 * MiB, A_HI = A_HQ + 16 * MiB, A_HG = A_HI + 16 * MiB, A_RY = A_HG + 16 * MiB;
constexpr size_t A_ZF0 = A_RY + 16 * MiB, A_ZF1 = A_ZF0 + 32 * MiB, A_RX = A_ZF1 + 32 * MiB;
constexpr size_t A_DQ = A_RX + 32 * MiB, A_DK = A_DQ + 32 * MiB, A_DV = A_DK + 32 * MiB;
constexpr size_t A_ST = A_DV + 32 * MiB;
constexpr size_t A_RGAGG = A_ST + 64 * MiB, A_RGCAR = A_RGAGG + 1 * MiB, A_HD = A_RGCAR + 1 * MiB, A_MIX_END = A_HD + 1 * MiB;
constexpr size_t A_P = WS_ARENA + 64 * MiB, A_LSUM = A_P + 64 * MiB;
constexpr size_t A_MEMB = A_LSUM + 4 * MiB, A_KMEM = A_MEMB + 1 * MiB, A_VMEM = A_KMEM + 2 * MiB;
constexpr size_t A_GATE = WS_ARENA + 64 * MiB, A_VAL = A_GATE + 176 * MiB, WS_END = A_VAL + 176 * MiB;
static_assert(WS_END <= 512 * MiB && A_MIX_END + 32 * MiB <= 512 * MiB, "workspace map");

constexpr int LDS_BYTES = 132096;
#ifndef PHMASK
#define PHMASK 0xFFFFFFFFu
#endif
#define PH(k) ((PHMASK >> (k)) & 1u)
#ifndef REPMASK
#define REPMASK 0u
#endif
#define REPS(k) ({ int r_ = 1 + (int)((REPMASK >> (k)) & 1u); asm volatile("" : "+s"(r_)); r_; })

struct Params { const void* in[30]; float* out; unsigned char* ws; };

__device__ __forceinline__ int ltid() { int t = threadIdx.x; asm volatile("" : "+v"(t)); return t; }
__device__ __forceinline__ int lbid() { int t = blockIdx.x; asm volatile("" : "+s"(t)); return t; }
__device__ __forceinline__ int lgdim() { int t = gridDim.x; asm volatile("" : "+s"(t)); return t; }
typedef float f32x2_cv __attribute__((ext_vector_type(2))); typedef __bf16 bf16x2_cv __attribute__((ext_vector_type(2)));
__device__ __forceinline__ unsigned pk2(float lo, float hi) { const f32x2_cv v = {lo, hi}; return __builtin_bit_cast(unsigned, __builtin_convertvector(v, bf16x2_cv)); }
__device__ __forceinline__ unsigned f2bf(float f) { return pk2(f, 0.f) & 0xffffu; }
__device__ __forceinline__ float bf2f(unsigned h) { return __builtin_bit_cast(float, h << 16); }
__device__ __forceinline__ float bflo(unsigned w) { return __builtin_bit_cast(float, w << 16); }
__device__ __forceinline__ float bfhi(unsigned w) { return __builtin_bit_cast(float, w & 0xffff0000u); }
__device__ __forceinline__ unsigned cvt_pk_bf16(float lo, float hi) { unsigned r; asm volatile("v_cvt_pk_bf16_f32 %0, %1, %2" : "=v"(r) : "v"(lo), "v"(hi)); return r; }
template <int CTRL> __device__ __forceinline__ float dppf(float v) { return __builtin_bit_cast(float, __builtin_amdgcn_update_dpp(0, __builtin_bit_cast(int, v), CTRL, 0xF, 0xF, true)); }
__device__ __forceinline__ float swap16_sum(float v) { auto r = __builtin_amdgcn_permlane16_swap(__float_as_uint(v), __float_as_uint(v), false, false); return __uint_as_float(r[0]) + __uint_as_float(r[1]); }
__device__ __forceinline__ float swap32_sum(float v) { auto r = __builtin_amdgcn_permlane32_swap(__float_as_uint(v), __float_as_uint(v), false, false); return __uint_as_float(r[0]) + __uint_as_float(r[1]); }
__device__ __forceinline__ float sum8(float v) { v += dppf<0xB1>(v); v += dppf<0x4E>(v); v += dppf<0x141>(v); return v; }
__device__ __forceinline__ float sum16(float v) { v = sum8(v); v += dppf<0x140>(v); return v; }
__device__ __forceinline__ float sum32(float v) { return swap16_sum(sum16(v)); }
__device__ __forceinline__ float sum64(float v) { return swap32_sum(sum32(v)); }
__device__ __forceinline__ float sigm(float x) { return __builtin_amdgcn_rcpf(1.f + __expf(-x)); }
__device__ __forceinline__ float siluf(float x) { return x * sigm(x); }
__device__ __forceinline__ float nexpm1(float x) { const float p = -x * (1.f + x * (0.5f + x * (0.16666667f + x * (0.041666668f + x * (0.0083333338f + x * 0.0013888889f))))); return x > -0.5f ? p : 1.f - __expf(x); }
__device__ __forceinline__ float gelu_tanh(float x) { const float t = x * (-2.3022082f + -0.10294324f * (x * x)); return x * __builtin_amdgcn_rcpf(1.f + __builtin_amdgcn_exp2f(t)); }
__device__ __forceinline__ u32x4 pack8(const float* v) { u32x4 w; w.x = cvt_pk_bf16(v[0], v[1]); w.y = cvt_pk_bf16(v[2], v[3]); w.z = cvt_pk_bf16(v[4], v[5]); w.w = cvt_pk_bf16(v[6], v[7]); return w; }
__device__ __forceinline__ void unpack8(u32x4 w, float* v) { v[0] = bflo(w.x); v[1] = bfhi(w.x); v[2] = bflo(w.y); v[3] = bfhi(w.y); v[4] = bflo(w.z); v[5] = bfhi(w.z); v[6] = bflo(w.w); v[7] = bfhi(w.w); }

namespace pg8 {
constexpr int BM = 256, BK = 64, HALF = 128, HTB = HALF * BK * 2, STAGE_BYTES = 8 * HTB, NXCD = 8, WGM = 8;
__host__ __device__ __forceinline__ int lds_byte(int r, int c) { const int st = (r >> 4) * 2 + (c >> 5), rr = r & 15, cc = c & 31, ob = rr * 64 + cc * 2; return st * 1024 + (ob ^ (((ob >> 9) & 1) << 5)); }
__host__ __device__ __forceinline__ void stage_rc(int b, int& R, int& C) { const int st = b / 1024, sb = b % 1024, swz = sb ^ (((sb >> 9) & 1) << 5); R = (st >> 1) * 16 + swz / 64; C = (st & 1) * 32 + (swz % 64) / 2; }
__host__ __device__ __forceinline__ int perm32(int rho) { const int n = rho >> 4, i = rho & 15; return 8 * (i >> 2) + 4 * n + (i & 3); }
struct Unit { int pm, pn; };
struct Gemm { const bf16_t* A; const bf16_t* Bt; int M, N, K, lda, ldb; int pm_per_batch; size_t b_batch_stride; };
struct StaticOrder {
    int nM, nN, nwg, G, c;
    __device__ void init(int M_, int N_, int G_, int c_) { nM = M_ / BM; nN = N_ / BM; nwg = nM * nN; G = G_; c = c_; }
    __device__ bool next(int i, Unit& u) const {
        const long L = (long)i * G + c; if (L >= nwg) return false;
        int wgid = (int)L; { const int q = nwg / NXCD, r = nwg % NXCD, xcd = wgid % NXCD, off = wgid / NXCD; wgid = (xcd < r ? xcd * (q + 1) : r * (q + 1) + (xcd - r) * q) + off; }
        const int nig = WGM * nN, gid = wgid / nig, fm = gid * WGM, gsz = (nM - fm) < WGM ? (nM - fm) : WGM;
        u.pm = fm + ((wgid % nig) % gsz); u.pn = (wgid % nig) / gsz; return true;
    }
};
template <class F> struct EpiRow8 {
    F f;
    __device__ __forceinline__ void operator()(const f32x4 (&acc)[2][2][4][2], const Unit& u, int wr, int wc, int fr, int fq) const {
        const int row0 = u.pm * BM + wr * 64 + fr, colb = u.pn * BM + wc * 32 + 8 * fq;
#pragma unroll
        for (int ai = 0; ai < 2; ++ai)
#pragma unroll
            for (int m = 0; m < 4; ++m)
            {
#pragma unroll
              for (int bj = 0; bj < 2; ++bj) f(row0 + ai * HALF + m * 16, colb + bj * HALF, acc[ai][bj][m][0], acc[ai][bj][m][1]);
              asm volatile("" ::: "memory"); }
    }
};

template <class Epi, bool APERM = false>
__device__ __forceinline__ void gemm_phase(LAS unsigned char* lds, const Gemm g, const StaticOrder& S, const Epi& E) {
    int tid_ = threadIdx.x; asm volatile("" : "+v"(tid_));
    const int tid = tid_, wid = __builtin_amdgcn_readfirstlane(tid >> 6), lane = tid & 63, wr = wid >> 2, wc = wid & 3, fr = lane & 15, fq = lane >> 4;
    const int K = g.K, nt = K / BK;
    unsigned voffA[2], voffB[2];
#pragma unroll
    for (int i = 0; i < 2; ++i) { int R, C; stage_rc(tid * 16 + i * 8192, R, C); const int Rb = (R & ~31) + perm32(R & 31);
        const int Ra = APERM ? (128 * (R >> 6) + 8 * (R & 15) + ((R >> 4) & 3)) : R;
        voffA[i] = (unsigned)(Ra * g.lda + C) * 2u; voffB[i] = (unsigned)(Rb * g.ldb + C) * 2u; }
    const size_t kstep = (size_t)(BK * 2);
    const size_t hstepA = (size_t)(APERM ? 4 : HALF) * g.lda * 2, hstepB = (size_t)HALF * g.ldb * 2;
    const size_t tstepA = (size_t)BM * g.lda * 2, tstepB = 2 * hstepB;
    const unsigned ldsw = (unsigned)wid * 1024u;
    const int aoff = lds_byte(wr * 64 + fr, fq * 8), boff = lds_byte(wc * 32 + fr, fq * 8);
#define PG8_SA(b, h) (((b) * 2 + (h)) * HTB)
#define PG8_SB(b, h) ((4 + (b) * 2 + (h)) * HTB)
#define PG8_STAGE(bufoff, gbase, voff) do { _Pragma("unroll") for (int _i = 0; _i < 2; ++_i) \
        __builtin_amdgcn_global_load_lds((const unsigned*)((const char*)(gbase) + (voff)[_i]), (LAS unsigned*)(lds + (bufoff) + ldsw + _i * 8192), 16, 0, 0); } while (0)
#define PG8_LDA(dst, b, h) do { _Pragma("unroll") for (int m = 0; m < 4; ++m) _Pragma("unroll") for (int k = 0; k < 2; ++k) dst[m][k] = *(const LAS bf16x8*)(lds + PG8_SA(b, h) + aoff + m * 2048 + k * 1024); } while (0)
#define PG8_LDB(dst, b, h) do { _Pragma("unroll") for (int n = 0; n < 2; ++n) _Pragma("unroll") for (int k = 0; k < 2; ++k) dst[n][k] = *(const LAS bf16x8*)(lds + PG8_SB(b, h) + boff + n * 2048 + k * 1024); } while (0)
#define PG8_MMA(ai, bj, At, Bt) do { __builtin_amdgcn_s_setprio(1); _Pragma("unroll") for (int m = 0; m < 4; ++m) _Pragma("unroll") for (int n = 0; n < 2; ++n) _Pragma("unroll") for (int k = 0; k < 2; ++k) \
        acc[ai][bj][m][n] = __builtin_amdgcn_mfma_f32_16x16x32_bf16(Bt[n][k], At[m][k], acc[ai][bj][m][n], 0, 0, 0); __builtin_amdgcn_s_setprio(0); } while (0)
#define PG8_WAIT_V(n) asm volatile("s_waitcnt vmcnt(" #n ")" ::: "memory")
#define PG8_WAIT_L(n) asm volatile("s_waitcnt lgkmcnt(" #n ")" ::: "memory")
#define PG8_BAR __builtin_amdgcn_s_barrier()
#define PG8_SCHED __builtin_amdgcn_sched_barrier(0)
    Unit cur, nxt; int ui = 0;
    if (!S.next(0, cur)) return;
    f32x4 acc[2][2][4][2];
#pragma unroll
    for (int a = 0; a < 2; ++a)
#pragma unroll
        for (int b = 0; b < 2; ++b)
#pragma unroll
            for (int m = 0; m < 4; ++m)
#pragma unroll
                for (int n = 0; n < 2; ++n) acc[a][b][m][n] = (f32x4){0.f, 0.f, 0.f, 0.f};
    bf16x8 At[4][2], B0[2][2], B1[2][2];
    const char* cA = (const char*)g.A + (size_t)cur.pm * tstepA;
    const char* cB = (const char*)g.Bt + (size_t)cur.pn * tstepB + (size_t)(cur.pm / g.pm_per_batch) * g.b_batch_stride * 2;
    PG8_WAIT_V(0);
    PG8_STAGE(PG8_SB(0, 0), cB, voffB); PG8_STAGE(PG8_SB(0, 1), cB + hstepB, voffB); PG8_STAGE(PG8_SA(0, 0), cA, voffA); PG8_STAGE(PG8_SA(0, 1), cA + hstepA, voffA);
    if (wr == 1) PG8_BAR;
    PG8_WAIT_V(2); PG8_BAR;
    PG8_STAGE(PG8_SB(1, 0), cB + kstep, voffB); PG8_STAGE(PG8_SA(1, 0), cA + kstep, voffA); PG8_STAGE(PG8_SB(1, 1), cB + hstepB + kstep, voffB);
    PG8_WAIT_V(6); PG8_BAR;
    for (;;) {
        const bool has_next = S.next(ui + 1, nxt);
        const char* nA = has_next ? (const char*)g.A + (size_t)nxt.pm * tstepA : cA;
        const char* nB = has_next ? (const char*)g.Bt + (size_t)nxt.pn * tstepB + (size_t)(nxt.pm / g.pm_per_batch) * g.b_batch_stride * 2 : cB;
        for (int t = 0; t < nt; t += 2) {
            const bool last = (t == nt - 2);
            const char* a1 = cA + (size_t)(t + 1) * kstep;
            const char* a2 = last ? nA : cA + (size_t)(t + 2) * kstep; const char* b2 = last ? nB : cB + (size_t)(t + 2) * kstep;
            const char* a3 = a2 + kstep; const char* b3 = b2 + kstep;
            PG8_LDB(B0, 0, 0); PG8_LDB(B1, 0, 1); PG8_SCHED; PG8_LDA(At, 0, 0); PG8_STAGE(PG8_SA(1, 1), a1 + hstepA, voffA);
            PG8_WAIT_V(8); PG8_WAIT_L(0); PG8_BAR; PG8_MMA(0, 0, At, B0); PG8_MMA(0, 1, At, B1); PG8_BAR; PG8_SCHED;
            PG8_LDA(At, 0, 1); PG8_STAGE(PG8_SB(0, 0), b2, voffB); PG8_STAGE(PG8_SB(0, 1), b2 + hstepB, voffB); PG8_STAGE(PG8_SA(0, 0), a2, voffA);
            PG8_WAIT_V(8); PG8_WAIT_L(0); PG8_BAR; PG8_MMA(1, 0, At, B0); PG8_MMA(1, 1, At, B1); PG8_BAR; PG8_SCHED;
            PG8_LDB(B0, 1, 0); PG8_LDB(B1, 1, 1); PG8_SCHED; PG8_LDA(At, 1, 0); PG8_STAGE(PG8_SA(0, 1), a2 + hstepA, voffA);
            PG8_WAIT_V(8); PG8_WAIT_L(0); PG8_BAR; PG8_MMA(0, 0, At, B0); PG8_MMA(0, 1, At, B1); PG8_BAR; PG8_SCHED;
            PG8_LDA(At, 1, 1); PG8_STAGE(PG8_SB(1, 0), b3, voffB); PG8_STAGE(PG8_SB(1, 1), b3 + hstepB, voffB); PG8_STAGE(PG8_SA(1, 0), a3, voffA);
            PG8_WAIT_V(8); PG8_WAIT_L(0); PG8_BAR; PG8_MMA(1, 0, At, B0); PG8_MMA(1, 1, At, B1); PG8_BAR; PG8_SCHED;
        }
        if (wr == 0) PG8_BAR;
        E(acc, cur, wr, wc, fr, fq);
        if (!has_next) break;
#pragma unroll
        for (int a = 0; a < 2; ++a)
#pragma unroll
            for (int b = 0; b < 2; ++b)
#pragma unroll
                for (int m = 0; m < 4; ++m)
#pragma unroll
                    for (int n = 0; n < 2; ++n) acc[a][b][m][n] = (f32x4){0.f, 0.f, 0.f, 0.f};
        cur = nxt; cA = nA; cB = nB; ++ui;
        if (wr == 1) PG8_BAR;
    }
    PG8_WAIT_V(0);
    PG8_BAR;
#undef PG8_SA
#undef PG8_SB
#undef PG8_STAGE
#undef PG8_LDA
#undef PG8_LDB
#undef PG8_MMA
#undef PG8_WAIT_V
#undef PG8_WAIT_L
#undef PG8_BAR
#undef PG8_SCHED
}
}

__device__ __forceinline__ void st8_bf16(bf16_t* p, const float* v) { *(u32x4*)p = pack8(v); }
__device__ __forceinline__ void st8_f32(float* p, const float* v) { *(f32x4*)p = (f32x4){v[0], v[1], v[2], v[3]}; *(f32x4*)(p + 4) = (f32x4){v[4], v[5], v[6], v[7]}; }

struct FProj {
    bf16_t *HQ, *HI, *HG, *RY, *DQ, *DK, *DV; float *ZF0, *ZF1, *RX; const float *cs, *sn;
    __device__ __forceinline__ void operator()(int row, int col, f32x4 v0, f32x4 v1) const {
        float v[8] = {v0[0], v0[1], v0[2], v0[3], v1[0], v1[1], v1[2], v1[3]};
        const int seg = col >> 8, c = col & 255;
        if (seg == 0) {
#pragma unroll
            for (int i = 0; i < 8; ++i) v[i] = siluf(v[i]);
            st8_bf16(HQ + (size_t)row * 256 + c, v);
        } else if (seg == 1) { st8_f32(ZF0 + (size_t)row * 256 + c, v);
        } else if (seg == 2) { st8_f32(ZF1 + (size_t)row * 256 + c, v);
        } else if (seg == 3) { st8_bf16(HI + (size_t)row * 256 + c, v);
        } else if (seg == 4) {
#pragma unroll
            for (int i = 0; i < 8; ++i) v[i] = siluf(v[i]);
            st8_bf16(HG + (size_t)row * 256 + c, v);
        } else if (seg == 5) { st8_f32(RX + (size_t)row * 256 + c, v);
        } else if (seg == 6) {
#pragma unroll
            for (int i = 0; i < 8; ++i) v[i] = gelu_tanh(v[i]);
            st8_bf16(RY + (size_t)row * 256 + c, v);
        } else if (seg <= 10) {
            const int cc = col - (seg <= 8 ? 1792 : 2304); const int i0 = (cc & 63) >> 1;
            const f32x4 cv = *(const f32x4*)(cs + (size_t)row * 32 + i0), sv = *(const f32x4*)(sn + (size_t)row * 32 + i0);
            float o[8];
#pragma unroll
            for (int k = 0; k < 4; ++k) { const float t1 = v[2 * k], t2 = v[2 * k + 1]; o[2 * k] = t1 * cv[k] - t2 * sv[k]; o[2 * k + 1] = t2 * cv[k] + t1 * sv[k]; }
            if (seg <= 8) {
#pragma unroll
                for (int k = 0; k < 8; ++k) o[k] *= 0.18033688011112042f;
            }
            st8_bf16((seg <= 8 ? DQ : DK) + (size_t)row * 512 + cc, o);
        } else { st8_bf16(DV + (size_t)row * 512 + (col - 2816), v); }
    }
};
struct FRes {
    const float* res; float* out; const float* st; const float* g; const float* b;
    __device__ __forceinline__ void operator()(int row, int col, f32x4 v0, f32x4 v1) const {
        const size_t o = (size_t)row * DM + col; f32x4 r0 = *(const f32x4*)(res + o), r1 = *(const f32x4*)(res + o + 4);
        if (st) { typedef float f32x2 __attribute__((ext_vector_type(2))); const f32x2 ms = *(const f32x2*)(st + (size_t)row * 2);
            r0 = (r0 - ms[0]) * ms[1] * *(const f32x4*)(g + col) + *(const f32x4*)(b + col); r1 = (r1 - ms[0]) * ms[1] * *(const f32x4*)(g + col + 4) + *(const f32x4*)(b + col + 4); }
        *(f32x4*)(out + o) = r0 * ALPHA + v0; *(f32x4*)(out + o + 4) = r1 * ALPHA + v1;
    }
};
struct EpiRes {
    const float* res; float* out; const float* st; const float* g; const float* b;
    __device__ __forceinline__ void operator()(const f32x4 (&acc)[2][2][4][2], const pg8::Unit& u, int wr, int wc, int fr, int fq) const {
        typedef float f32x2 __attribute__((ext_vector_type(2)));
        const int row0 = u.pm * 256 + wr * 64 + fr, colb = u.pn * 256 + wc * 32 + 8 * fq;
#pragma unroll
        for (int ai = 0; ai < 2; ++ai)
#pragma unroll
        for (int mh = 0; mh < 2; ++mh) {
            f32x4 r[2][2][2]; f32x2 ms[2];
#pragma unroll
            for (int mm = 0; mm < 2; ++mm) { const int m = mh * 2 + mm; const size_t o = (size_t)(row0 + ai * 128 + m * 16) * DM + colb;
                r[mm][0][0] = *(const f32x4*)(res + o); r[mm][0][1] = *(const f32x4*)(res + o + 4); r[mm][1][0] = *(const f32x4*)(res + o + 128); r[mm][1][1] = *(const f32x4*)(res + o + 132);
                ms[mm] = st ? *(const f32x2*)(st + (size_t)(row0 + ai * 128 + m * 16) * 2) : (f32x2){0.f, 1.f}; }
#pragma unroll
            for (int bj = 0; bj < 2; ++bj) {
                f32x4 g0 = {1.f, 1.f, 1.f, 1.f}, g1 = g0, b0 = {0.f, 0.f, 0.f, 0.f}, b1 = b0;
                if (st) { g0 = *(const f32x4*)(g + colb + bj * 128); g1 = *(const f32x4*)(g + colb + bj * 128 + 4); b0 = *(const f32x4*)(b + colb + bj * 128); b1 = *(const f32x4*)(b + colb + bj * 128 + 4); }
#pragma unroll
                for (int mm = 0; mm < 2; ++mm) { const int m = mh * 2 + mm; const size_t o = (size_t)(row0 + ai * 128 + m * 16) * DM + colb + bj * 128;
                    f32x4 x0 = r[mm][bj][0], x1 = r[mm][bj][1];
                    if (st) { x0 = (x0 - ms[mm][0]) * ms[mm][1] * g0 + b0; x1 = (x1 - ms[mm][0]) * ms[mm][1] * g1 + b1; }
                    *(f32x4*)(out + o) = x0 * ALPHA + acc[ai][bj][m][0]; *(f32x4*)(out + o + 4) = x1 * ALPHA + acc[ai][bj][m][1]; }
            }
            asm volatile("" ::: "memory");
        }
    }
};
struct FScores {
    bf16_t* P; float* LS;
    __device__ __forceinline__ void operator()(int row, int col, f32x4 v0, f32x4 v1) const {
        float e[8];
#pragma unroll
        for (int i = 0; i < 4; ++i) { e[i] = __expf(v0[i] * 0.0625f - 10.f); e[4 + i] = __expf(v1[i] * 0.0625f - 10.f); }
        const u32x4 w = pack8(e); *(u32x4*)(P + (size_t)row * DM + col) = w;
        float s = (bflo(w.x) + bfhi(w.x)) + (bflo(w.y) + bfhi(w.y)) + (bflo(w.z) + bfhi(w.z)) + (bflo(w.w) + bfhi(w.w));
        s = swap32_sum(swap16_sum(s));
        if ((ltid() & 63) < 16) LS[(size_t)row * 32 + (col >> 8) * 8 + ((col & 255) >> 5)] = s;
    }
};
struct FStore {
    bf16_t* O; int ldc;
    __device__ __forceinline__ void operator()(int row, int col, f32x4 v0, f32x4 v1) const {
        const float v[8] = {v0[0], v0[1], v0[2], v0[3], v1[0], v1[1], v1[2], v1[3]}; st8_bf16(O + (size_t)row * ldc + col, v);
    }
};
struct FUp {
    bf16_t *G, *V;
    __device__ __forceinline__ void operator()(int row, int col, f32x4 v0, f32x4 v1) const {
        const float v[8] = {v0[0], v0[1], v0[2], v0[3], v1[0], v1[1], v1[2], v1[3]};
        if (col < DFF) st8_bf16(G + (size_t)row * DFF + col, v); else st8_bf16(V + (size_t)row * DFF + (col - DFF), v);
    }
};


struct EpiUpConv {
    bf16_t* H; float* SB; const float* cw; const float* cb;
    __device__ __forceinline__ void operator()(const f32x4 (&acc)[2][2][4][2], const pg8::Unit& u, int wr, int wc, int fr, int fq) const {
        const int T0 = u.pm * 256 + wr * 128 + fr * 8, grp = u.pm * 2 + wr;
#pragma unroll
        for (int n = 0; n < 2; ++n) {
            const int c = u.pn * 128 + wc * 32 + fq * 8 + n * 4;
            const f32x4 w0 = *(const f32x4*)(cw + c), w1 = *(const f32x4*)(cw + DFF + c), w2 = *(const f32x4*)(cw + 2 * DFF + c), bb = *(const f32x4*)(cb + c);
            f32x4 gp, gn;
#pragma unroll
            for (int e = 0; e < 4; ++e) { gp[e] = dppf<0x111>(acc[1][0][3][n][e]); gn[e] = dppf<0x101>(acc[0][0][0][n][e]); }
#pragma unroll
            for (int k = 0; k < 8; ++k) {
                const f32x4 gc = acc[k >> 2][0][k & 3][n];
                const f32x4 gl = (k == 0) ? gp : acc[(k - 1) >> 2][0][(k - 1) & 3][n];
                const f32x4 gr = (k == 7) ? gn : acc[(k + 1) >> 2][0][(k + 1) & 3][n];
                const f32x4 vv = acc[k >> 2][1][k & 3][n];
                const bool edgeF = (k == 0) && (fr == 0), edgeL = (k == 7) && (fr == 15);
                if (edgeF) { const size_t o = (size_t)grp * DFF + c; *(f32x4*)(SB + 0 * 256 * (size_t)DFF + o) = w1 * gc + w2 * gr + bb; *(f32x4*)(SB + 1 * 256 * (size_t)DFF + o) = vv; *(f32x4*)(SB + 2 * 256 * (size_t)DFF + o) = gc; }
                else if (edgeL) { const size_t o = (size_t)grp * DFF + c; *(f32x4*)(SB + 3 * 256 * (size_t)DFF + o) = w0 * gl + w1 * gc + bb; *(f32x4*)(SB + 4 * 256 * (size_t)DFF + o) = vv; *(f32x4*)(SB + 5 * 256 * (size_t)DFF + o) = gc; }
                else { const f32x4 a = w0 * gl + w1 * gc + w2 * gr + bb;
                    u32x2 w; w.x = cvt_pk_bf16(gelu_tanh(a[0]) * vv[0], gelu_tanh(a[1]) * vv[1]); w.y = cvt_pk_bf16(gelu_tanh(a[2]) * vv[2], gelu_tanh(a[3]) * vv[3]);
                    *(u32x2*)(H + (size_t)(T0 + k) * DFF + c) = w; }
            }
            asm volatile("" ::: "memory");
        }
    }
};

namespace att {
constexpr int NW = 8, QBLK = 32, KVBLK = 64, LDQ = 512;
constexpr float SCALE = 0.125f, THR = 8.f;
constexpr int SHM_V = KVBLK * 128 * 2, SHM_K = KVBLK * 64 * 2;
#define KSWZ(row, colB) ((row) * 128 + ((colB) ^ ((((row) >> 1) & 7) << 4)))
#define SBAR() __builtin_amdgcn_sched_barrier(0)
__device__ __forceinline__ int crow(int r, int hi) { return (r & 3) + 8 * (r >> 2) + 4 * hi; }
__device__ __forceinline__ void partialSM(f32x16& p0, f32x16& p1, float& m_ref, float& alpha, bool first) {
  constexpr float THRL = THR * 1.4426950408889634f;
  float pmax = p0[0];
#pragma unroll
  for (int r = 1; r < 16; ++r) pmax = fmaxf(pmax, p0[r]);
#pragma unroll
  for (int r = 0; r < 16; ++r) pmax = fmaxf(pmax, p1[r]);
  { auto rr = __builtin_amdgcn_permlane32_swap(__float_as_uint(pmax), __float_as_uint(pmax), false, false);
    pmax = fmaxf(__uint_as_float(rr[0]), __uint_as_float(rr[1])); }
  if (__builtin_expect(!first && __all(pmax <= THRL), 1)) { alpha = 1.f; }
  else { const float dl = first ? pmax : fmaxf(pmax, 0.f); m_ref += dl; alpha = first ? 1.f : __builtin_amdgcn_exp2f(-dl);
#pragma unroll
    for (int r = 0; r < 16; ++r) { p0[r] -= dl; p1[r] -= dl; } }
#pragma unroll
  for (int r = 0; r < 16; ++r) p0[r] = __builtin_amdgcn_exp2f(p0[r]);
}
__device__ __forceinline__ void finishSM(f32x16& p0, f32x16& p1, float alpha, float& l_reg, bf16x8& pa0, bf16x8& pa1, bf16x8& pa2, bf16x8& pa3) {
#pragma unroll
  for (int r = 0; r < 16; ++r) p1[r] = __builtin_amdgcn_exp2f(p1[r]);
  float ps = 0;
#pragma unroll
  for (int r = 0; r < 16; ++r) ps += p0[r];
#pragma unroll
  for (int r = 0; r < 16; ++r) ps += p1[r];
  { auto rr = __builtin_amdgcn_permlane32_swap(__float_as_uint(ps), __float_as_uint(ps), false, false);
    ps = __uint_as_float(rr[0]) + __uint_as_float(rr[1]); }
  l_reg = l_reg * alpha + ps;
#define PK4(P, BASE, OUT) do { unsigned a0 = cvt_pk_bf16(P[BASE + 0], P[BASE + 1]), a1 = cvt_pk_bf16(P[BASE + 2], P[BASE + 3]);   \
    unsigned b0 = cvt_pk_bf16(P[BASE + 4], P[BASE + 5]), b1 = cvt_pk_bf16(P[BASE + 6], P[BASE + 7]);                              \
    auto r0 = __builtin_amdgcn_permlane32_swap(a0, b0, false, false); auto r1 = __builtin_amdgcn_permlane32_swap(a1, b1, false, false); \
    u32x4 w = {r0[0], r1[0], r0[1], r1[1]}; OUT = *reinterpret_cast<bf16x8*>(&w); } while (0)
  PK4(p0, 0, pa0); PK4(p0, 8, pa1); PK4(p1, 0, pa2); PK4(p1, 8, pa3);
#undef PK4
}
__device__ __forceinline__ void qkt(f32x16& p0, f32x16& p1, const char* Ks, const bf16x8* qr, int r32, int hi, float m_ref) {
#pragma unroll
  for (int r = 0; r < 16; ++r) { p0[r] = -m_ref; p1[r] = -m_ref; }
#pragma unroll
  for (int d0 = 0; d0 < 4; ++d0) { const int cb = (d0 * 16 + hi * 8) * 2;
    bf16x8 b0 = *reinterpret_cast<const bf16x8*>(Ks + KSWZ(r32, cb));
    bf16x8 b1 = *reinterpret_cast<const bf16x8*>(Ks + KSWZ(32 + r32, cb));
    p0 = __builtin_amdgcn_mfma_f32_32x32x16_bf16(b0, qr[d0], p0, 0, 0, 0);
    p1 = __builtin_amdgcn_mfma_f32_32x32x16_bf16(b1, qr[d0], p1, 0, 0, 0); }
}
__device__ __forceinline__ int v_st(int k, int c) { const int kk = (k & ~0xC) | ((k & 4) << 1) | ((k & 8) >> 1); return ((kk >> 3) * 4 + (c >> 5)) * 512 + ((kk & 7) * 32 + (c & 31)) * 2; }
__device__ __forceinline__ int v_rd_base(int lane) { return ((lane & 3) << 3) | (((lane >> 2) & 3) << 6) | (((lane >> 4) & 1) << 5) | (((lane >> 5) & 1) << 8); }
constexpr int v_rd_off(int d0, int ks, int half) { return d0 * 512 + ks * 4096 + half * 2048; }
template <int OFF> __device__ __forceinline__ s16x4 tr_read(int vb) {
  s16x4 r; asm volatile("ds_read_b64_tr_b16 %0, %1 offset:%2" : "=&v"(r) : "v"(vb), "i"(OFF) : "memory"); return r;
}
template <int D0> __device__ __forceinline__ void pv_one(f32x16& od, int vb, bf16x8 pa0, bf16x8 pa1, bf16x8 pa2, bf16x8 pa3) {
  const s16x4 l0 = tr_read<v_rd_off(D0, 0, 0)>(vb), h0 = tr_read<v_rd_off(D0, 0, 1)>(vb), l1 = tr_read<v_rd_off(D0, 1, 0)>(vb), h1 = tr_read<v_rd_off(D0, 1, 1)>(vb);
  const s16x4 l2 = tr_read<v_rd_off(D0, 2, 0)>(vb), h2 = tr_read<v_rd_off(D0, 2, 1)>(vb), l3 = tr_read<v_rd_off(D0, 3, 0)>(vb), h3 = tr_read<v_rd_off(D0, 3, 1)>(vb);
  asm volatile("s_waitcnt lgkmcnt(0)" ::: "memory"); SBAR();
#define PK(L, H) (bf16x8){L[0], L[1], L[2], L[3], H[0], H[1], H[2], H[3]}
  od = __builtin_amdgcn_mfma_f32_32x32x16_bf16(pa0, PK(l0, h0), od, 0, 0, 0);
  od = __builtin_amdgcn_mfma_f32_32x32x16_bf16(pa1, PK(l1, h1), od, 0, 0, 0);
  od = __builtin_amdgcn_mfma_f32_32x32x16_bf16(pa2, PK(l2, h2), od, 0, 0, 0);
  od = __builtin_amdgcn_mfma_f32_32x32x16_bf16(pa3, PK(l3, h3), od, 0, 0, 0);
#undef PK
}
__device__ __forceinline__ void pv_d0(f32x16* o, int vb, bf16x8 pa0, bf16x8 pa1, bf16x8 pa2, bf16x8 pa3) {
  pv_one<0>(o[0], vb, pa0, pa1, pa2, pa3); pv_one<1>(o[1], vb, pa0, pa1, pa2, pa3); pv_one<2>(o[2], vb, pa0, pa1, pa2, pa3); pv_one<3>(o[3], vb, pa0, pa1, pa2, pa3);
}
__device__ __forceinline__ void attn_unit(const bf16_t* __restrict__ Qb, const bf16_t* __restrict__ Kh, const bf16_t* __restrict__ Vh, int seq, char* lds,
                                          int mode, float* scratch, float lam, float gscale, const float* __restrict__ subg, bf16_t* outp) {
  int tid_ = threadIdx.x; asm volatile("" : "+v"(tid_));
  const int tid = tid_, wid = tid >> 6, lane = tid & 63, r32 = lane & 31, hi = lane >> 5;
  char* V_lds = lds; char* K_lds = lds + 3 * SHM_V;
  float* ws = (float*)(lds + 3 * SHM_V + 3 * SHM_K) + wid * 64; float* li_l = ws; float* al_l = ws + 32;
  float m_reg = 0.f, l_reg = 0; f32x16 o[4] = {}; bf16x8 qr[4];
  const bf16_t* Qw = Qb + (long)(wid * QBLK + r32) * LDQ + hi * 8;
#pragma unroll
  for (int d0 = 0; d0 < 4; ++d0) qr[d0] = *reinterpret_cast<const bf16x8*>(Qw + d0 * 16);
  const int sr = tid >> 4, sc = (tid & 15) * 8, vst0 = v_st(sr, sc), vst1 = v_st(32 + sr, sc);
  const int kr = tid >> 3, kc = (tid & 7) * 8, kst = KSWZ(kr, kc * 2);
  const int vb0 = (int)(uintptr_t)V_lds + v_rd_base(lane);
  struct { bf16x8 vs0, vs1, ks0; } sr_[2];
#define SLOAD(i, k0) do { sr_[i].vs0 = *reinterpret_cast<const bf16x8*>(&Vh[(long)((k0) + sr) * LDQ + sc]); sr_[i].vs1 = *reinterpret_cast<const bf16x8*>(&Vh[(long)((k0) + 32 + sr) * LDQ + sc]); \
    sr_[i].ks0 = *reinterpret_cast<const bf16x8*>(&Kh[(long)((k0) + kr) * LDQ + kc]); } while (0)
#define SWRITE(b, i) do { *(bf16x8*)(V_lds + (b) * SHM_V + vst0) = sr_[i].vs0; *(bf16x8*)(V_lds + (b) * SHM_V + vst1) = sr_[i].vs1; \
    *(bf16x8*)(K_lds + (b) * SHM_K + kst) = sr_[i].ks0; } while (0)
#define SWAIT() asm volatile("s_waitcnt vmcnt(3)" ::: "memory")
#define RESC(a) do { if (__any((a) < 1.f)) { if (hi == 0) al_l[r32] = (a); asm volatile("s_waitcnt lgkmcnt(0)" ::: "memory"); \
    _Pragma("unroll") for (int d = 0; d < 4; ++d) _Pragma("unroll") for (int r = 0; r < 16; ++r) o[d][r] *= al_l[crow(r, hi)]; } } while (0)
  f32x16 pA0, pA1, pB0, pB1; float alA, alB; bf16x8 pa0, pa1, pa2, pa3; const int NT = seq / KVBLK;
  constexpr int SE = 0, SO = 1;
  SLOAD(SE, 0); asm volatile("s_waitcnt vmcnt(0)" ::: "memory"); SWRITE(0, SE); __syncthreads();
  qkt(pA0, pA1, K_lds, qr, r32, hi, m_reg); partialSM(pA0, pA1, m_reg, alA, true);
  SLOAD(SO, KVBLK); if (2 < NT) SLOAD(SE, 2 * KVBLK);
  SWAIT(); SWRITE(1, SO); __syncthreads();
  int bp = 0, bc = 1, bn = 2;
#define ROT3() do { const int t_ = bp; bp = bc; bc = bn; bn = t_; } while (0)
  if (wid >= 4) __builtin_amdgcn_s_setprio(1);
  for (int j = 1; j + 1 < NT; j += 2) {
    SBAR(); qkt(pB0, pB1, K_lds + bc * SHM_K, qr, r32, hi, m_reg);
    finishSM(pA0, pA1, alA, l_reg, pa0, pa1, pa2, pa3); SBAR();
    SLOAD(SO, (j + 2) * KVBLK); SBAR();
    pv_d0(o, vb0 + bp * SHM_V, pa0, pa1, pa2, pa3); partialSM(pB0, pB1, m_reg, alB, false);
    SWAIT(); SWRITE(bn, SE);
    RESC(alB); __syncthreads(); ROT3();
    SBAR(); qkt(pA0, pA1, K_lds + bc * SHM_K, qr, r32, hi, m_reg);
    finishSM(pB0, pB1, alB, l_reg, pa0, pa1, pa2, pa3); SBAR();
    if (j + 3 < NT) SLOAD(SE, (j + 3) * KVBLK); SBAR();
    pv_d0(o, vb0 + bp * SHM_V, pa0, pa1, pa2, pa3); partialSM(pA0, pA1, m_reg, alA, false);
    SWAIT(); SWRITE(bn, SO);
    RESC(alA); __syncthreads(); ROT3();
  }
  SBAR(); qkt(pB0, pB1, K_lds + bc * SHM_K, qr, r32, hi, m_reg);
  finishSM(pA0, pA1, alA, l_reg, pa0, pa1, pa2, pa3); SBAR();
  pv_d0(o, vb0 + bp * SHM_V, pa0, pa1, pa2, pa3); partialSM(pB0, pB1, m_reg, alB, false);
  RESC(alB);
  finishSM(pB0, pB1, alB, l_reg, pa0, pa1, pa2, pa3); SBAR();
  pv_d0(o, vb0 + bc * SHM_V, pa0, pa1, pa2, pa3);
  __builtin_amdgcn_s_setprio(0);
#undef ROT3
  if (hi == 0) li_l[r32] = l_reg; asm volatile("s_waitcnt lgkmcnt(0)" ::: "memory");
  float* sw = scratch + (long)(wid * QBLK) * 128;
  if (mode == 0) {
#pragma unroll
    for (int r = 0; r < 16; ++r) { const int orow = crow(r, hi); const float rl = __builtin_amdgcn_rcpf(li_l[orow]);
#pragma unroll
      for (int d0 = 0; d0 < 4; ++d0) sw[orow * 128 + d0 * 32 + r32] = o[d0][r] * rl; }
  } else {
    bf16_t* ow = outp + (long)(wid * QBLK) * 1024;
    float g4[4];
#pragma unroll
    for (int d0 = 0; d0 < 4; ++d0) g4[d0] = subg[d0 * 32 + r32] * gscale;
#pragma unroll
    for (int r = 0; r < 16; ++r) { const int orow = crow(r, hi); const float rl = __builtin_amdgcn_rcpf(li_l[orow]) * lam;
      float x[4]; float ss = 0.f;
#pragma unroll
      for (int d0 = 0; d0 < 4; ++d0) { x[d0] = sw[orow * 128 + d0 * 32 + r32] - o[d0][r] * rl; ss += x[d0] * x[d0]; }
      ss = sum32(ss);
      const float rn = rsqrtf(ss * (1.f / 128.f) + 1e-6f);
#pragma unroll
      for (int d0 = 0; d0 < 4; ++d0) ow[orow * 1024 + d0 * 32 + r32] = (bf16_t)f2bf(x[d0] * rn * g4[d0]); }
  }
  __syncthreads();
#undef SLOAD
#undef SWRITE
#undef SWAIT
#undef RESC
}
#undef KSWZ
#undef SBAR
}

namespace hg {
constexpr int ST = 65;
constexpr int O_Q = 0, O_K = 4160, O_B = 8320, O_QB = 12480, O_KS = 16640, O_V = 22880, O_S = 26976, O_TMP = 31072;
__device__ __forceinline__ int ksbase(int I) { return I == 0 ? O_KS : I == 1 ? O_KS + 16 * ST : I == 2 ? O_KS + 48 * ST : O_K; }
__device__ __forceinline__ f32x4 mm4(float a, float b, f32x4 c) { return __builtin_amdgcn_mfma_f32_16x16x4f32(a, b, c, 0, 0, 0); }
__device__ __forceinline__ void load_gates(LAS float* sm, const float* ZF, const float* lbt, int tok0, int h, int dir, int tid) {
    const int tl = tid >> 3, c8 = (tid & 7) * 8, j = dir ? 63 - tl : tl;
    const float* zp = ZF + (size_t)(tok0 + tl) * 256 + h * 64 + c8;
    const f32x4 z0 = *(const f32x4*)zp, z1 = *(const f32x4*)(zp + 4);
    const f32x4 l0 = *(const f32x4*)(lbt + h * 64 + c8), l1 = *(const f32x4*)(lbt + h * 64 + c8 + 4);
    const float z[8] = {z0[0], z0[1], z0[2], z0[3], z1[0], z1[1], z1[2], z1[3]}, lb[8] = {l0[0], l0[1], l0[2], l0[3], l1[0], l1[1], l1[2], l1[3]};
#pragma unroll
    for (int e = 0; e < 8; ++e) { const float sg = __builtin_amdgcn_rcpf(1.f + __expf(-z[e])); const float f = lb[e] + (1.f - lb[e]) * sg;
        sm[O_B + j * ST + c8 + e] = __logf(f); sm[O_K + j * ST + c8 + e] = (1.f - lb[e]) * __builtin_amdgcn_rcpf(1.f + __expf(z[e])); }
}
__device__ __forceinline__ void cumsum_b(LAS float* sm, int tid) {
    const int d = tid & 63, seg = tid >> 6; float run = 0.f;
#pragma unroll
    for (int r = 0; r < 8; ++r) { const int ix = O_B + (seg * 8 + r) * ST + d; run += sm[ix]; sm[ix] = run; }
    sm[O_TMP + seg * 64 + d] = run;
    __syncthreads();
    float off = 0.f;
    for (int s = 0; s < seg; ++s) off += sm[O_TMP + s * 64 + d];
#pragma unroll
    for (int r = 0; r < 8; ++r) sm[O_B + (seg * 8 + r) * ST + d] += off;
    __syncthreads();
}
__device__ __forceinline__ void load_bf16_tile(LAS float* dst, int stride, const bf16_t* src, int tok0, int h, int dir, int tid) {
    const int tl = tid >> 3, c8 = (tid & 7) * 8, j = dir ? 63 - tl : tl;
    const u32x4 w = *(const u32x4*)(src + (size_t)(tok0 + tl) * 256 + h * 64 + c8); float v[8]; unpack8(w, v);
#pragma unroll
    for (int e = 0; e < 8; ++e) dst[j * stride + c8 + e] = v[e];
}
__device__ __forceinline__ void unit_a(LAS float* sm, int u, const float* ZF0, const float* ZF1, const bf16_t* HI, const float* lbt, float* STB, float* HD) {
    const int tid = ltid(), lane = tid & 63, w = tid >> 6; const int chunk = u & 255, dir = (u >> 8) & 1, h = (u >> 9) & 3, b = u >> 11;
    const int tok0 = b * SEQ + chunk * 64;
    load_gates(sm, dir ? ZF1 : ZF0, lbt + dir * 256, tok0, h, dir, tid);
    load_bf16_tile(sm + O_V, 64, HI, tok0, h, dir, tid);
    __syncthreads();
    cumsum_b(sm, tid);
    { const int d = tid & 63, seg = tid >> 6; const float bl = sm[O_B + 63 * ST + d];
#pragma unroll
      for (int r = 0; r < 8; ++r) { const int ix = (seg * 8 + r) * ST + d; sm[O_K + ix] *= __expf(bl - sm[O_B + ix]); } }
    __syncthreads();
    const int stream = (b * 4 + h) * 2 + dir, p = dir ? 255 - chunk : chunk;
    const int fr = lane & 15, fq = lane >> 4;
#pragma unroll
    for (int tt = 0; tt < 2; ++tt) { const int T = 2 * w + tt, di = T >> 2, ei = T & 3; f32x4 acc = {0.f, 0.f, 0.f, 0.f};
#pragma unroll 4
        for (int k0 = 0; k0 < 64; k0 += 4) acc = mm4(sm[O_K + (k0 + fq) * ST + 16 * di + fr], sm[O_V + (k0 + fq) * 64 + 16 * ei + fr], acc);
        asm volatile("s_nop 15\n\ts_nop 7" : "+v"(acc));
        float* up = STB + ((size_t)(stream * 256 + p)) * 4096 + (16 * di + 4 * fq) * 64 + 16 * ei + fr;
#pragma unroll
        for (int r = 0; r < 4; ++r) up[r * 64] = acc[r]; }
    if (tid < 64) HD[(size_t)(stream * 256 + p) * 64 + tid] = __expf(sm[O_B + 63 * ST + tid]);
    __syncthreads();
}
struct PreA { f32x4 z0, z1; u32x4 v; };
__device__ __forceinline__ PreA issue_a(int u, const float* ZF0, const float* ZF1, const bf16_t* HI, int tid) {
    const int chunk = u & 255, dir = (u >> 8) & 1, h = (u >> 9) & 3, b = u >> 11; const int tok0 = b * SEQ + chunk * 64; const int tl = tid >> 3, c8 = (tid & 7) * 8;
    const float* zp = (dir ? ZF1 : ZF0) + (size_t)(tok0 + tl) * 256 + h * 64 + c8;
    PreA p; p.z0 = *(const f32x4*)zp; p.z1 = *(const f32x4*)(zp + 4); p.v = *(const u32x4*)(HI + (size_t)(tok0 + tl) * 256 + h * 64 + c8); return p;
}
__device__ __forceinline__ void unit_a_pre(LAS float* sm, int u, const PreA& pre, const float* lbt0, float* STB, float* HD, int tid) {
    const int lane = tid & 63, w = __builtin_amdgcn_readfirstlane(tid >> 6); const int chunk = u & 255, dir = (u >> 8) & 1, h = (u >> 9) & 3, b = u >> 11;
    { const int tl = tid >> 3, c8 = (tid & 7) * 8, j = dir ? 63 - tl : tl; const float* lbt = lbt0 + dir * 256;
      const f32x4 l0 = *(const f32x4*)(lbt + h * 64 + c8), l1 = *(const f32x4*)(lbt + h * 64 + c8 + 4);
      const float z[8] = {pre.z0[0], pre.z0[1], pre.z0[2], pre.z0[3], pre.z1[0], pre.z1[1], pre.z1[2], pre.z1[3]}, lb[8] = {l0[0], l0[1], l0[2], l0[3], l1[0], l1[1], l1[2], l1[3]};
      float v[8]; unpack8(pre.v, v);
#pragma unroll
      for (int e = 0; e < 8; ++e) { const float sg = __builtin_amdgcn_rcpf(1.f + __expf(-z[e])); const float f = lb[e] + (1.f - lb[e]) * sg;
          sm[O_B + j * ST + c8 + e] = __logf(f); sm[O_K + j * ST + c8 + e] = (1.f - lb[e]) * __builtin_amdgcn_rcpf(1.f + __expf(z[e])); sm[O_V + j * 64 + c8 + e] = v[e]; } }
    __syncthreads();
    cumsum_b(sm, tid);
    { const int d = tid & 63, seg = tid >> 6; const float bl = sm[O_B + 63 * ST + d];
#pragma unroll
      for (int r = 0; r < 8; ++r) { const int ix = (seg * 8 + r) * ST + d; sm[O_K + ix] *= __expf(bl - sm[O_B + ix]); } }
    __syncthreads();
    const int stream = (b * 4 + h) * 2 + dir, p = dir ? 255 - chunk : chunk;
    const int fr = lane & 15, fq = lane >> 4;
#pragma unroll
    for (int tt = 0; tt < 2; ++tt) { const int T = 2 * w + tt, di = T >> 2, ei = T & 3; f32x4 acc = {0.f, 0.f, 0.f, 0.f};
#pragma unroll 4
        for (int k0 = 0; k0 < 64; k0 += 4) acc = mm4(sm[O_K + (k0 + fq) * ST + 16 * di + fr], sm[O_V + (k0 + fq) * 64 + 16 * ei + fr], acc);
        asm volatile("s_nop 15\n\ts_nop 7" : "+v"(acc));
        float* up = STB + ((size_t)(stream * 256 + p)) * 4096 + (16 * di + 4 * fq) * 64 + 16 * ei + fr;
#pragma unroll
        for (int r = 0; r < 4; ++r) up[r * 64] = acc[r]; }
    if (tid < 64) HD[(size_t)(stream * 256 + p) * 64 + tid] = __expf(sm[O_B + 63 * ST + tid]);
    __syncthreads();
}
__device__ __forceinline__ void phase_a(LAS float* sm, int bx, int G, const float* ZF0, const float* ZF1, const bf16_t* HI, const float* lbt0, float* STB, float* HD) {
    const int tid = ltid(); int u = bx; if (u >= 4096) return;
    PreA pre = issue_a(u, ZF0, ZF1, HI, tid);
#pragma unroll 1
    for (; u < 4096; u += G) { PreA nxt = pre; if (u + G < 4096) nxt = issue_a(u + G, ZF0, ZF1, HI, tid);
        unit_a_pre(sm, u, pre, lbt0, STB, HD, tid); pre = nxt; }
}
__device__ __forceinline__ void phase_b(float* STB, const float* HD) {
    const int gid = lbid() * 512 + ltid(); if (gid >= 65536) return;
    const int stream = gid >> 12, de = gid & 4095, d = de >> 6;
    float* sp = STB + (size_t)stream * 256 * 4096 + de; const float* dp = HD + (size_t)stream * 256 * 64 + d;
    float S = 0.f;
    for (int p = 0; p < 256; p += 32) {
        float uu[32], dc[32];
#pragma unroll
        for (int i = 0; i < 32; ++i) { uu[i] = sp[(size_t)(p + i) * 4096]; dc[i] = dp[(p + i) * 64]; }
#pragma unroll
        for (int i = 0; i < 32; ++i) { sp[(size_t)(p + i) * 4096] = S; S = dc[i] * S + uu[i]; }
    }
}
__device__ __forceinline__ void unit_c(LAS float* sm, int u, const float* ZF0, const float* ZF1, const bf16_t* HQ, const bf16_t* HI, const bf16_t* HGs, const float* lbt, const float* STB,
                                       const float* normg, bf16_t* MIX) {
    const int tid = ltid(), lane = tid & 63, w = tid >> 6; const int chunk = u & 255, h = (u >> 8) & 3, b = u >> 10;
    const int tok0 = b * SEQ + chunk * 64; const int fr = lane & 15, fq = lane >> 4;
    f32x4 oacc[2] = {{0.f, 0.f, 0.f, 0.f}, {0.f, 0.f, 0.f, 0.f}};
#pragma unroll 1
    for (int dir = 0; dir < 2; ++dir) {
        load_gates(sm, dir ? ZF1 : ZF0, lbt + dir * 256, tok0, h, dir, tid);
        load_bf16_tile(sm + O_Q, ST, HQ, tok0, h, dir, tid);
        load_bf16_tile(sm + O_V, 64, HI, tok0, h, dir, tid);
        { const int stream = (b * 4 + h) * 2 + dir, p = dir ? 255 - chunk : chunk; const float* sp = STB + ((size_t)(stream * 256 + p)) * 4096 + tid * 8;
          *(LAS f32x4*)(sm + O_S + tid * 8) = *(const f32x4*)sp; *(LAS f32x4*)(sm + O_S + tid * 8 + 4) = *(const f32x4*)(sp + 4); }
        __syncthreads();
        cumsum_b(sm, tid);
        { const int d = tid & 63, seg = tid >> 6, I = seg >> 1;
          float rj[4]; rj[0] = 0.f; rj[1] = sm[O_B + 15 * ST + d]; rj[2] = sm[O_B + 31 * ST + d]; rj[3] = sm[O_B + 47 * ST + d];
#pragma unroll
          for (int r = 0; r < 8; ++r) { const int ix = (seg * 8 + r) * ST + d; const float bt = sm[O_B + ix], q = sm[O_Q + ix], k = sm[O_K + ix];
              sm[O_QB + ix] = q * __expf(bt);
              sm[O_Q + ix] = q * __expf(bt - (I == 0 ? rj[0] : I == 1 ? rj[1] : I == 2 ? rj[2] : rj[3]));
#pragma unroll
              for (int J = 0; J < 4; ++J) if (J >= I) sm[ksbase(J) + ix] = k * __expf(fminf(rj[J] - bt, 80.f)); } }
        __syncthreads();
#pragma unroll 1
        for (int T = w; T < 10; T += 8) {
            const int I = T < 1 ? 0 : T < 3 ? 1 : T < 6 ? 2 : 3, J = T - (I * (I + 1)) / 2; const int kb = ksbase(I); f32x4 acc = {0.f, 0.f, 0.f, 0.f};
#pragma unroll 4
            for (int k0 = 0; k0 < 64; k0 += 4) acc = mm4(sm[O_Q + (16 * I + fr) * ST + k0 + fq], sm[kb + (16 * J + fr) * ST + k0 + fq], acc);
            asm volatile("s_nop 15\n\ts_nop 7" : "+v"(acc));
#pragma unroll
            for (int r = 0; r < 4; ++r) { const int t = 16 * I + 4 * fq + r, sx = 16 * J + fr; sm[O_B + t * ST + sx] = (sx <= t) ? acc[r] : 0.f; } }
        __syncthreads();
#pragma unroll
        for (int tt = 0; tt < 2; ++tt) { const int T = 2 * w + tt, ti = T >> 2, ei = T & 3; const int j = dir ? 63 - (16 * ti + fr) : 16 * ti + fr; const int ks = dir ? 4 * (4 - ti) : 4 * (ti + 1);
            f32x4 acc = {0.f, 0.f, 0.f, 0.f};
#pragma unroll 4
            for (int k0 = 0; k0 < 64; k0 += 4) acc = mm4(sm[O_QB + j * ST + k0 + fq], sm[O_S + (k0 + fq) * 64 + 16 * ei + fr], acc);
            for (int kk = 0; kk < ks; ++kk) acc = mm4(sm[O_B + j * ST + 4 * kk + fq], sm[O_V + (4 * kk + fq) * 64 + 16 * ei + fr], acc);
            asm volatile("s_nop 15\n\ts_nop 7" : "+v"(acc)); oacc[tt] += acc; }
        __syncthreads();
    }
#pragma unroll
    for (int tt = 0; tt < 2; ++tt) { const int T = 2 * w + tt, ti = T >> 2, ei = T & 3;
#pragma unroll
        for (int r = 0; r < 4; ++r) sm[O_Q + (16 * ti + 4 * fq + r) * ST + 16 * ei + fr] = oacc[tt][r]; }
    __syncthreads();
    const int tl = tid >> 3, e0 = (tid & 7) * 8;
    float ov[8]; float ss = 0.f;
#pragma unroll
    for (int e = 0; e < 8; ++e) { ov[e] = sm[O_Q + tl * ST + e0 + e]; ss += ov[e] * ov[e]; }
    ss = sum8(ss);
    const float rn = rsqrtf(ss * (1.f / 64.f) + 1e-6f);
    const size_t tok = (size_t)(tok0 + tl);
    float gv[8]; unpack8(*(const u32x4*)(HGs + tok * 256 + h * 64 + e0), gv);
    const f32x4 n0 = *(const f32x4*)(normg + h * 64 + e0), n1 = *(const f32x4*)(normg + h * 64 + e0 + 4);
    const float ng[8] = {n0[0], n0[1], n0[2], n0[3], n1[0], n1[1], n1[2], n1[3]};
#pragma unroll
    for (int e = 0; e < 8; ++e) ov[e] = ov[e] * rn * ng[e] * gv[e];
    st8_bf16(MIX + tok * 1024 + h * 64 + e0, ov);
    __syncthreads();
}
struct PreC { f32x4 z0, z1, s0, s1; u32x4 q, v; };
__device__ __forceinline__ PreC issue_c(int u, int dir, const float* ZF0, const float* ZF1, const bf16_t* HQ, const bf16_t* HI, const float* STB, int tid) {
    const int chunk = u & 255, h = (u >> 8) & 3, b = u >> 10; const int tok0 = b * SEQ + chunk * 64; const int tl = tid >> 3, c8 = (tid & 7) * 8;
    const float* zp = (dir ? ZF1 : ZF0) + (size_t)(tok0 + tl) * 256 + h * 64 + c8;
    const int stream = (b * 4 + h) * 2 + dir, p = dir ? 255 - chunk : chunk; const float* sp = STB + ((size_t)(stream * 256 + p)) * 4096 + tid * 8;
    PreC r; r.z0 = *(const f32x4*)zp; r.z1 = *(const f32x4*)(zp + 4); r.q = *(const u32x4*)(HQ + (size_t)(tok0 + tl) * 256 + h * 64 + c8); r.v = *(const u32x4*)(HI + (size_t)(tok0 + tl) * 256 + h * 64 + c8);
    r.s0 = *(const f32x4*)sp; r.s1 = *(const f32x4*)(sp + 4); return r;
}
__device__ __forceinline__ void phase_c(LAS float* sm, int bx, int G, const float* ZF0, const float* ZF1, const bf16_t* HQ, const bf16_t* HI, const bf16_t* HGs, const float* lbt, const float* STB,
                                        const float* normg, bf16_t* MIX) {
    const int tid = ltid(), lane = tid & 63, w = __builtin_amdgcn_readfirstlane(tid >> 6); const int fr = lane & 15, fq = lane >> 4;
    int u = bx; if (u >= 2048) return;
    PreC pre = issue_c(u, 0, ZF0, ZF1, HQ, HI, STB, tid);
#pragma unroll 1
    for (; u < 2048; u += G) {
    const int chunk = u & 255, h = (u >> 8) & 3, b = u >> 10; const int tok0 = b * SEQ + chunk * 64;
    f32x4 oacc[2] = {{0.f, 0.f, 0.f, 0.f}, {0.f, 0.f, 0.f, 0.f}};
#pragma unroll 1
    for (int dir = 0; dir < 2; ++dir) {
        {
            const int tl = tid >> 3, c8 = (tid & 7) * 8, j = dir ? 63 - tl : tl; const float* lbd = lbt + dir * 256;
            const f32x4 l0 = *(const f32x4*)(lbd + h * 64 + c8), l1 = *(const f32x4*)(lbd + h * 64 + c8 + 4);
            const float z[8] = {pre.z0[0], pre.z0[1], pre.z0[2], pre.z0[3], pre.z1[0], pre.z1[1], pre.z1[2], pre.z1[3]}, lb[8] = {l0[0], l0[1], l0[2], l0[3], l1[0], l1[1], l1[2], l1[3]};
            float qv[8], vv[8]; unpack8(pre.q, qv); unpack8(pre.v, vv);
#pragma unroll
            for (int e = 0; e < 8; ++e) { const float sg = __builtin_amdgcn_rcpf(1.f + __expf(-z[e])); const float f = lb[e] + (1.f - lb[e]) * sg;
                sm[O_B + j * ST + c8 + e] = __logf(f); sm[O_K + j * ST + c8 + e] = (1.f - lb[e]) * __builtin_amdgcn_rcpf(1.f + __expf(z[e]));
                sm[O_Q + j * ST + c8 + e] = qv[e]; sm[O_V + j * 64 + c8 + e] = vv[e]; }
            *(LAS f32x4*)(sm + O_S + tid * 8) = pre.s0; *(LAS f32x4*)(sm + O_S + tid * 8 + 4) = pre.s1;
            if (dir == 0) pre = issue_c(u, 1, ZF0, ZF1, HQ, HI, STB, tid); else if (u + G < 2048) pre = issue_c(u + G, 0, ZF0, ZF1, HQ, HI, STB, tid);
        }
        __syncthreads();
        cumsum_b(sm, tid);
        { const int d = tid & 63, seg = tid >> 6, I = seg >> 1;
          float rj[4]; rj[0] = 0.f; rj[1] = sm[O_B + 15 * ST + d]; rj[2] = sm[O_B + 31 * ST + d]; rj[3] = sm[O_B + 47 * ST + d];
#pragma unroll
          for (int r = 0; r < 8; ++r) { const int ix = (seg * 8 + r) * ST + d; const float bt = sm[O_B + ix], q = sm[O_Q + ix], k = sm[O_K + ix];
              sm[O_QB + ix] = q * __expf(bt);
              sm[O_Q + ix] = q * __expf(bt - (I == 0 ? rj[0] : I == 1 ? rj[1] : I == 2 ? rj[2] : rj[3]));
#pragma unroll
              for (int J = 0; J < 4; ++J) if (J >= I) sm[ksbase(J) + ix] = k * __expf(fminf(rj[J] - bt, 80.f)); } }
        __syncthreads();
#pragma unroll 1
        for (int T = w; T < 10; T += 8) {
            const int I = T < 1 ? 0 : T < 3 ? 1 : T < 6 ? 2 : 3, J = T - (I * (I + 1)) / 2; const int kb = ksbase(I); f32x4 acc = {0.f, 0.f, 0.f, 0.f};
#pragma unroll 4
            for (int k0 = 0; k0 < 64; k0 += 4) acc = mm4(sm[O_Q + (16 * I + fr) * ST + k0 + fq], sm[kb + (16 * J + fr) * ST + k0 + fq], acc);
            asm volatile("s_nop 15\n\ts_nop 7" : "+v"(acc));
#pragma unroll
            for (int r = 0; r < 4; ++r) { const int t = 16 * I + 4 * fq + r, sx = 16 * J + fr; sm[O_B + t * ST + sx] = (sx <= t) ? acc[r] : 0.f; } }
        __syncthreads();
#pragma unroll
        for (int tt = 0; tt < 2; ++tt) { const int T = 2 * w + tt, ti = T >> 2, ei = T & 3; const int j = dir ? 63 - (16 * ti + fr) : 16 * ti + fr; const int ks = dir ? 4 * (4 - ti) : 4 * (ti + 1);
            f32x4 acc = {0.f, 0.f, 0.f, 0.f};
#pragma unroll 4
            for (int k0 = 0; k0 < 64; k0 += 4) acc = mm4(sm[O_QB + j * ST + k0 + fq], sm[O_S + (k0 + fq) * 64 + 16 * ei + fr], acc);
            for (int kk = 0; kk < ks; ++kk) acc = mm4(sm[O_B + j * ST + 4 * kk + fq], sm[O_V + (4 * kk + fq) * 64 + 16 * ei + fr], acc);
            asm volatile("s_nop 15\n\ts_nop 7" : "+v"(acc)); oacc[tt] += acc; }
        __syncthreads();
    }
#pragma unroll
    for (int tt = 0; tt < 2; ++tt) { const int T = 2 * w + tt, ti = T >> 2, ei = T & 3;
#pragma unroll
        for (int r = 0; r < 4; ++r) sm[O_Q + (16 * ti + 4 * fq + r) * ST + 16 * ei + fr] = oacc[tt][r]; }
    const int tl = tid >> 3, e0 = (tid & 7) * 8;
    const u32x4 hgw = *(const u32x4*)(HGs + (size_t)(tok0 + tl) * 256 + h * 64 + e0);
    const f32x4 n0 = *(const f32x4*)(normg + h * 64 + e0), n1 = *(const f32x4*)(normg + h * 64 + e0 + 4);
    __syncthreads();
    float ov[8]; float ss = 0.f;
#pragma unroll
    for (int e = 0; e < 8; ++e) { ov[e] = sm[O_Q + tl * ST + e0 + e]; ss += ov[e] * ov[e]; }
    ss = sum8(ss);
    const float rn = rsqrtf(ss * (1.f / 64.f) + 1e-6f);
    const size_t tok = (size_t)(tok0 + tl);
    float gv[8]; unpack8(hgw, gv);
    const float ng[8] = {n0[0], n0[1], n0[2], n0[3], n1[0], n1[1], n1[2], n1[3]};
#pragma unroll
    for (int e = 0; e < 8; ++e) ov[e] = ov[e] * rn * ng[e] * gv[e];
    st8_bf16(MIX + tok * 1024 + h * 64 + e0, ov);
    __syncthreads();
    }
}
}

namespace rg {
constexpr int XS = 65, XBS = 72;
constexpr int OB_XC = 0, OB_XB = 33280, OB_WT = 51712, OB_AGG = 88576;
struct PreR { f32x4 x[2][4][2]; };
__device__ __forceinline__ PreR issue_r(int u, const float* RX, int tid) {
    const int chunk = u & 127, n = (u >> 7) & 3, b = u >> 9; const int t0 = chunk * 128; PreR r;
#pragma unroll
    for (int i2 = 0; i2 < 2; ++i2) { const int it = tid + i2 * 512; const int tl = it >> 3, c8 = (it & 7) * 8; const int ch = n * 64 + c8;
#pragma unroll
        for (int jj = 0; jj < 4; ++jj) { const int t = t0 + tl - 2 + jj; const bool ok = (t >= 0 && t < SEQ);
            const float* xp = RX + ((size_t)b * SEQ + (ok ? t : 0)) * 256 + ch;
            const f32x4 x0 = *(const f32x4*)xp, x1 = *(const f32x4*)(xp + 4); const f32x4 zz = {0.f, 0.f, 0.f, 0.f};
            r.x[i2][jj][0] = ok ? x0 : zz; r.x[i2][jj][1] = ok ? x1 : zz; } }
    return r;
}
template <bool FULL>
__device__ __forceinline__ void unit(LAS unsigned char* smb, int u, const float* RX, const bf16_t* RYg, const float* cw, const float* cb, const bf16_t* RGW, const float* ba, const float* bx,
                                     const float* lamp, float* AGG, const float* CAR, bf16_t* MIX) {
    const int tid = ltid(), lane = tid & 63, w = tid >> 6, fr = lane & 15, fq = lane >> 4; const int chunk = u & 127, n = (u >> 7) & 3, b = u >> 9;
    const int t0 = chunk * 128;
    LAS float* sxc = (LAS float*)(smb + OB_XC); LAS float* sag = (LAS float*)(smb + OB_AGG);
    { const bf16_t* src = RGW + (size_t)n * 16384;
#pragma unroll
      for (int q = 0; q < 4; ++q) { const int cidx = tid + q * 512, row = cidx >> 3, c8 = (cidx & 7) * 8;
          *(LAS u32x4*)(smb + OB_WT + (row * XBS + c8) * 2) = *(const u32x4*)(src + (size_t)row * 64 + c8); } }
    for (int it = tid; it < 128 * 8; it += 512) { const int tl = it >> 3, c8 = (it & 7) * 8; const int ch = n * 64 + c8;
        float a[8];
        { const f32x4 b0 = *(const f32x4*)(cb + ch), b1 = *(const f32x4*)(cb + ch + 4); a[0] = b0[0]; a[1] = b0[1]; a[2] = b0[2]; a[3] = b0[3]; a[4] = b1[0]; a[5] = b1[1]; a[6] = b1[2]; a[7] = b1[3]; }
#pragma unroll
        for (int jj = 0; jj < 4; ++jj) { const int t = t0 + tl - 2 + jj; if (t < 0 || t >= SEQ) continue;
            const float* xp = RX + ((size_t)b * SEQ + t) * 256 + ch; const f32x4 x0 = *(const f32x4*)xp, x1 = *(const f32x4*)(xp + 4);
            const f32x4 w0 = *(const f32x4*)(cw + jj * 256 + ch), w1 = *(const f32x4*)(cw + jj * 256 + ch + 4);
            a[0] += w0[0] * x0[0]; a[1] += w0[1] * x0[1]; a[2] += w0[2] * x0[2]; a[3] += w0[3] * x0[3]; a[4] += w1[0] * x1[0]; a[5] += w1[1] * x1[1]; a[6] += w1[2] * x1[2]; a[7] += w1[3] * x1[3]; }
#pragma unroll
        for (int e = 0; e < 8; ++e) sxc[tl * XS + c8 + e] = a[e];
        *(LAS u32x4*)(smb + OB_XB + (tl * XBS + c8) * 2) = pack8(a); }
    __syncthreads();
    f32x4 acc[4][4];
    { const bf16x8 a0 = *(const LAS bf16x8*)(smb + OB_XB + ((16 * w + fr) * XBS + 8 * fq) * 2), a1 = *(const LAS bf16x8*)(smb + OB_XB + ((16 * w + fr) * XBS + 32 + 8 * fq) * 2);
#pragma unroll
      for (int g = 0; g < 4; ++g)
#pragma unroll
          for (int cg = 0; cg < 4; ++cg) { const int wb = OB_WT + ((g * 64 + 16 * cg + fr) * XBS + 8 * fq) * 2;
              const bf16x8 b0 = *(const LAS bf16x8*)(smb + wb), b1 = *(const LAS bf16x8*)(smb + wb + 64);
              f32x4 c = {0.f, 0.f, 0.f, 0.f}; c = __builtin_amdgcn_mfma_f32_16x16x32_bf16(a0, b0, c, 0, 0, 0); acc[g][cg] = __builtin_amdgcn_mfma_f32_16x16x32_bf16(a1, b1, c, 0, 0, 0); } }
    float av0[16], uv0[16], av1[16], uv1[16];
    const int run = 4 * w + fq;
#pragma unroll
    for (int cg = 0; cg < 4; ++cg) { const int ch = n * 64 + 16 * cg + fr;
        const float ba0 = ba[ch], ba1 = ba[256 + ch], bx0 = bx[ch], bx1 = bx[256 + ch];
        const float sp0 = log1pf(__expf(-lamp[ch])), sp1 = log1pf(__expf(-lamp[256 + ch]));
        float Af = 1.f, Bf = 0.f, Ab = 1.f, Bb = 0.f;
#pragma unroll
        for (int r = 0; r < 4; ++r) { const float xc = sxc[(16 * w + 4 * fq + r) * XS + 16 * cg + fr];
            { const float rr = sigm(acc[0][cg][r] + ba0), ig = sigm(acc[2][cg][r] + bx0); const float la = -8.f * rr * sp0; av0[cg * 4 + r] = __expf(la); uv0[cg * 4 + r] = __builtin_amdgcn_sqrtf(nexpm1(2.f * la)) * (ig * xc); }
            { const float rr = sigm(acc[1][cg][r] + ba1), ig = sigm(acc[3][cg][r] + bx1); const float la = -8.f * rr * sp1; av1[cg * 4 + r] = __expf(la); uv1[cg * 4 + r] = __builtin_amdgcn_sqrtf(nexpm1(2.f * la)) * (ig * xc); }
            Bf = av0[cg * 4 + r] * Bf + uv0[cg * 4 + r]; Af *= av0[cg * 4 + r]; Bb += Ab * uv1[cg * 4 + r]; Ab *= av1[cg * 4 + r]; }
        sag[((0 * 32 + run) * 64 + 16 * cg + fr) * 2] = Af; sag[((0 * 32 + run) * 64 + 16 * cg + fr) * 2 + 1] = Bf;
        sag[((1 * 32 + run) * 64 + 16 * cg + fr) * 2] = Ab; sag[((1 * 32 + run) * 64 + 16 * cg + fr) * 2 + 1] = Bb; }
    __syncthreads();
    if (tid < 128) { const int dir = tid >> 6, j = tid & 63, ch = n * 64 + j;
        if (!FULL) { float A = 1.f, Bv = 0.f;
            if (dir == 0) { for (int s = 0; s < 32; ++s) { const float a = sag[((0 * 32 + s) * 64 + j) * 2], bb = sag[((0 * 32 + s) * 64 + j) * 2 + 1]; Bv = a * Bv + bb; A *= a; } }
            else { for (int s = 31; s >= 0; --s) { const float a = sag[((1 * 32 + s) * 64 + j) * 2], bb = sag[((1 * 32 + s) * 64 + j) * 2 + 1]; Bv = a * Bv + bb; A *= a; } }
            float* ap = AGG + ((size_t)((b * 2 + dir) * 128 + chunk) * 256 + ch) * 2; ap[0] = A; ap[1] = Bv;
        } else { float hc = CAR[(size_t)((b * 2 + dir) * 128 + chunk) * 256 + ch];
            if (dir == 0) { for (int s = 0; s < 32; ++s) { const int ix = ((0 * 32 + s) * 64 + j) * 2; const float a = sag[ix], bb = sag[ix + 1]; sag[ix] = hc; hc = a * hc + bb; } }
            else { for (int s = 31; s >= 0; --s) { const int ix = ((1 * 32 + s) * 64 + j) * 2; const float a = sag[ix], bb = sag[ix + 1]; sag[ix] = hc; hc = a * hc + bb; } } } }
    if (FULL) {
        __syncthreads();
        const size_t tokb = (size_t)b * SEQ + t0 + 16 * w + 4 * fq;
#pragma unroll
        for (int cg = 0; cg < 4; ++cg) { const int ch = n * 64 + 16 * cg + fr;
            float hf = sag[((0 * 32 + run) * 64 + 16 * cg + fr) * 2], hb = sag[((1 * 32 + run) * 64 + 16 * cg + fr) * 2]; float hs[4];
#pragma unroll
            for (int r = 0; r < 4; ++r) { hf = av0[cg * 4 + r] * hf + uv0[cg * 4 + r]; hs[r] = hf; }
#pragma unroll
            for (int r = 3; r >= 0; --r) { hb = av1[cg * 4 + r] * hb + uv1[cg * 4 + r]; hs[r] += hb; }
#pragma unroll
            for (int r = 0; r < 4; ++r) { const float y = bf2f(RYg[(tokb + r) * 256 + ch]); MIX[(tokb + r) * 1024 + 256 + ch] = (bf16_t)f2bf(hs[r] * y); } }
    }
    __syncthreads();
}
template <bool FULL>
__device__ __forceinline__ void unit_pre(LAS unsigned char* smb, int u, const PreR& pre, int pre_tid, const bf16_t* RYg, const float* cw, const float* cb, const bf16_t* RGW, const float* ba, const float* bx,
                                     const float* lamp, float* AGG, const float* CAR, bf16_t* MIX) {
    const int tid = pre_tid, lane = tid & 63, w = __builtin_amdgcn_readfirstlane(tid >> 6), fr = lane & 15, fq = lane >> 4; const int chunk = u & 127, n = (u >> 7) & 3, b = u >> 9;
    const int t0 = chunk * 128;
    LAS float* sxc = (LAS float*)(smb + OB_XC); LAS float* sag = (LAS float*)(smb + OB_AGG);
    float gc[4][6];
#pragma unroll
    for (int cg = 0; cg < 4; ++cg) { const int ch = n * 64 + 16 * cg + fr; gc[cg][0] = ba[ch]; gc[cg][1] = ba[256 + ch]; gc[cg][2] = bx[ch]; gc[cg][3] = bx[256 + ch]; gc[cg][4] = lamp[ch]; gc[cg][5] = lamp[256 + ch]; }
    float car_pre = 0.f; if (FULL && tid < 128) car_pre = CAR[(size_t)((b * 2 + (tid >> 6)) * 128 + chunk) * 256 + n * 64 + (tid & 63)];
    { const bf16_t* src = RGW + (size_t)n * 16384;
#pragma unroll
      for (int q = 0; q < 4; ++q) { const int cidx = tid + q * 512, row = cidx >> 3, c8 = (cidx & 7) * 8;
          *(LAS u32x4*)(smb + OB_WT + (row * XBS + c8) * 2) = *(const u32x4*)(src + (size_t)row * 64 + c8); } }
#pragma unroll
    for (int i2 = 0; i2 < 2; ++i2) { const int it = tid + i2 * 512; const int tl = it >> 3, c8 = (it & 7) * 8; const int ch = n * 64 + c8;
        float a[8];
        { const f32x4 b0 = *(const f32x4*)(cb + ch), b1 = *(const f32x4*)(cb + ch + 4); a[0] = b0[0]; a[1] = b0[1]; a[2] = b0[2]; a[3] = b0[3]; a[4] = b1[0]; a[5] = b1[1]; a[6] = b1[2]; a[7] = b1[3]; }
#pragma unroll
        for (int jj = 0; jj < 4; ++jj) { const f32x4 x0 = pre.x[i2][jj][0], x1 = pre.x[i2][jj][1];
            const f32x4 w0 = *(const f32x4*)(cw + jj * 256 + ch), w1 = *(const f32x4*)(cw + jj * 256 + ch + 4);
            a[0] += w0[0] * x0[0]; a[1] += w0[1] * x0[1]; a[2] += w0[2] * x0[2]; a[3] += w0[3] * x0[3]; a[4] += w1[0] * x1[0]; a[5] += w1[1] * x1[1]; a[6] += w1[2] * x1[2]; a[7] += w1[3] * x1[3]; }
#pragma unroll
        for (int e = 0; e < 8; ++e) sxc[tl * XS + c8 + e] = a[e];
        *(LAS u32x4*)(smb + OB_XB + (tl * XBS + c8) * 2) = pack8(a); }
    __syncthreads();
    f32x4 acc[4][4];
    { const bf16x8 a0 = *(const LAS bf16x8*)(smb + OB_XB + ((16 * w + fr) * XBS + 8 * fq) * 2), a1 = *(const LAS bf16x8*)(smb + OB_XB + ((16 * w + fr) * XBS + 32 + 8 * fq) * 2);
#pragma unroll
      for (int g = 0; g < 4; ++g)
#pragma unroll
          for (int cg = 0; cg < 4; ++cg) { const int wb = OB_WT + ((g * 64 + 16 * cg + fr) * XBS + 8 * fq) * 2;
              const bf16x8 b0 = *(const LAS bf16x8*)(smb + wb), b1 = *(const LAS bf16x8*)(smb + wb + 64);
              f32x4 c = {0.f, 0.f, 0.f, 0.f}; c = __builtin_amdgcn_mfma_f32_16x16x32_bf16(a0, b0, c, 0, 0, 0); acc[g][cg] = __builtin_amdgcn_mfma_f32_16x16x32_bf16(a1, b1, c, 0, 0, 0); } }
    float av0[16], uv0[16], av1[16], uv1[16];
    const int run = 4 * w + fq;
    unsigned short ryv[16];
    if (FULL) { const size_t tokb_ = (size_t)b * SEQ + t0 + 16 * w + 4 * fq;
#pragma unroll
        for (int cg = 0; cg < 4; ++cg)
#pragma unroll
            for (int r = 0; r < 4; ++r) ryv[cg * 4 + r] = RYg[(tokb_ + r) * 256 + n * 64 + 16 * cg + fr]; }
#pragma unroll
    for (int cg = 0; cg < 4; ++cg) { const int ch = n * 64 + 16 * cg + fr;
        const float ba0 = gc[cg][0], ba1 = gc[cg][1], bx0 = gc[cg][2], bx1 = gc[cg][3];
        const float sp0 = log1pf(__expf(-gc[cg][4])), sp1 = log1pf(__expf(-gc[cg][5]));
        float Af = 1.f, Bf = 0.f, Ab = 1.f, Bb = 0.f;
#pragma unroll
        for (int r = 0; r < 4; ++r) { const float xc = sxc[(16 * w + 4 * fq + r) * XS + 16 * cg + fr];
            { const float rr = sigm(acc[0][cg][r] + ba0), ig = sigm(acc[2][cg][r] + bx0); const float la = -8.f * rr * sp0; av0[cg * 4 + r] = __expf(la); uv0[cg * 4 + r] = __builtin_amdgcn_sqrtf(nexpm1(2.f * la)) * (ig * xc); }
            { const float rr = sigm(acc[1][cg][r] + ba1), ig = sigm(acc[3][cg][r] + bx1); const float la = -8.f * rr * sp1; av1[cg * 4 + r] = __expf(la); uv1[cg * 4 + r] = __builtin_amdgcn_sqrtf(nexpm1(2.f * la)) * (ig * xc); }
            Bf = av0[cg * 4 + r] * Bf + uv0[cg * 4 + r]; Af *= av0[cg * 4 + r]; Bb += Ab * uv1[cg * 4 + r]; Ab *= av1[cg * 4 + r]; }
        sag[((0 * 32 + run) * 64 + 16 * cg + fr) * 2] = Af; sag[((0 * 32 + run) * 64 + 16 * cg + fr) * 2 + 1] = Bf;
        sag[((1 * 32 + run) * 64 + 16 * cg + fr) * 2] = Ab; sag[((1 * 32 + run) * 64 + 16 * cg + fr) * 2 + 1] = Bb; }
    __syncthreads();
    if (tid < 128) { const int dir = tid >> 6, j = tid & 63, ch = n * 64 + j;
        if (!FULL) { float A = 1.f, Bv = 0.f;
            if (dir == 0) { for (int s = 0; s < 32; ++s) { const float a = sag[((0 * 32 + s) * 64 + j) * 2], bb = sag[((0 * 32 + s) * 64 + j) * 2 + 1]; Bv = a * Bv + bb; A *= a; } }
            else { for (int s = 31; s >= 0; --s) { const float a = sag[((1 * 32 + s) * 64 + j) * 2], bb = sag[((1 * 32 + s) * 64 + j) * 2 + 1]; Bv = a * Bv + bb; A *= a; } }
            float* ap = AGG + ((size_t)((b * 2 + dir) * 128 + chunk) * 256 + ch) * 2; ap[0] = A; ap[1] = Bv;
        } else { float hc = car_pre;
            if (dir == 0) { for (int s = 0; s < 32; ++s) { const int ix = ((0 * 32 + s) * 64 + j) * 2; const float a = sag[ix], bb = sag[ix + 1]; sag[ix] = hc; hc = a * hc + bb; } }
            else { for (int s = 31; s >= 0; --s) { const int ix = ((1 * 32 + s) * 64 + j) * 2; const float a = sag[ix], bb = sag[ix + 1]; sag[ix] = hc; hc = a * hc + bb; } } } }
    if (FULL) {
        __syncthreads();
        const size_t tokb = (size_t)b * SEQ + t0 + 16 * w + 4 * fq;
#pragma unroll
        for (int cg = 0; cg < 4; ++cg) { const int ch = n * 64 + 16 * cg + fr;
            float hf = sag[((0 * 32 + run) * 64 + 16 * cg + fr) * 2], hb = sag[((1 * 32 + run) * 64 + 16 * cg + fr) * 2]; float hs[4];
#pragma unroll
            for (int r = 0; r < 4; ++r) { hf = av0[cg * 4 + r] * hf + uv0[cg * 4 + r]; hs[r] = hf; }
#pragma unroll
            for (int r = 3; r >= 0; --r) { hb = av1[cg * 4 + r] * hb + uv1[cg * 4 + r]; hs[r] += hb; }
#pragma unroll
            for (int r = 0; r < 4; ++r) { const float y = bf2f(ryv[cg * 4 + r]); MIX[(tokb + r) * 1024 + 256 + ch] = (bf16_t)f2bf(hs[r] * y); } }
    }
    __syncthreads();
}
template <bool FULL>
__device__ __forceinline__ void phase_rg(LAS unsigned char* smb, int blk, int G, const float* RX, const bf16_t* RYg, const float* cw, const float* cb, const bf16_t* RGW, const float* ba, const float* bx,
                                         const float* lamp, float* AGG, const float* CAR, bf16_t* MIX) {
    const int tid = ltid(); int u = blk; if (u >= 1024) return;
    PreR pre = issue_r(u, RX, tid);
#pragma unroll 1
    for (; u < 1024; u += G) { PreR nxt = pre; if (u + G < 1024) nxt = issue_r(u + G, RX, tid);
        unit_pre<FULL>(smb, u, pre, tid, RYg, cw, cb, RGW, ba, bx, lamp, AGG, CAR, MIX); pre = nxt; }
}
}

template <int MODE>
__device__ __forceinline__ void p0_transpose_item(const float* W, int K, int N, bf16_t* WT, LAS float* scr, int item, int lane) {
    const int nblk = N / 32, kb = item / nblk, nb = item % nblk, k0 = 64 * kb, n0 = 32 * nb;
#pragma unroll 16
    for (int i = 0; i < 32; ++i) { const int kk = 2 * i + (lane >> 5); scr[kk * 33 + (lane & 31)] = W[(size_t)(k0 + kk) * N + n0 + (lane & 31)]; }
    asm volatile("s_waitcnt lgkmcnt(0)" ::: "memory");
    const int c = lane & 7;
#pragma unroll
    for (int jx = 0; jx < 4; ++jx) { const int n = (lane >> 3) + 8 * jx; const LAS float* s = scr + (8 * c) * 33 + n;
        u32x4 o; o.x = pk2(s[0 * 33], s[1 * 33]); o.y = pk2(s[2 * 33], s[3 * 33]); o.z = pk2(s[4 * 33], s[5 * 33]); o.w = pk2(s[6 * 33], s[7 * 33]);
        int nr = n0 + n;
        if (MODE == 1) { if (nr >= 1792 && nr < 2816) { const int l = nr & 63; nr = (nr & ~63) + ((l & 31) << 1) + (l >> 5); } }
        if (MODE == 2) { if (nr < DFF) nr = ((nr >> 7) << 8) + (nr & 127); else { const int cc = nr - DFF; nr = ((cc >> 7) << 8) + 128 + (cc & 127); } }
        *(u32x4*)(WT + (size_t)nr * K + k0 + 8 * c) = o; }
    asm volatile("s_waitcnt lgkmcnt(0)" ::: "memory");
}

#define XB_TMO      128
#define XB_XCNT(j)  (256  + 64 * (j))
#define XB_XSUB(j)  (1280 + 64 * (j))
#define XB_XGEN(j)  (2304 + 64 * (j))
#define XB_TOP      3328
#define XB_TOPGEN   3392
#define XCD_BAR_WORDS 3456
#define XB_SPIN_CAP (1u << 18)

__device__ __forceinline__ unsigned xb_ld(unsigned* p)              { return __hip_atomic_load(p, __ATOMIC_RELAXED, __HIP_MEMORY_SCOPE_AGENT); }
__device__ __forceinline__ unsigned xb_add(unsigned* p, unsigned v) { return __hip_atomic_fetch_add(p, v, __ATOMIC_RELAXED, __HIP_MEMORY_SCOPE_AGENT); }
__device__ __forceinline__ unsigned xb_xcc_id() { return (unsigned)__builtin_amdgcn_s_getreg((3 << 11) | 20) & 0xFu; }
#define XB_SPIN(cond, bar) do { unsigned _sp = 0; while (cond) { __builtin_amdgcn_s_sleep(1); \
    if ((++_sp & 255u) == 0u) { if (xb_ld(&(bar)[XB_TMO])) break; if (_sp > XB_SPIN_CAP) { atomicAdd(&(bar)[XB_TMO], 1u); break; } } } } while (0)

struct XcdBarrier {
    unsigned* bar; unsigned x;
    volatile LAS unsigned* st;
};

__device__ __forceinline__ XcdBarrier xcd_barrier_post(unsigned* bar, volatile LAS unsigned* st) {
    XcdBarrier b; b.bar = bar; b.x = xb_xcc_id(); b.st = st;
    if (threadIdx.x == 0) (void)xb_add(&bar[XB_XCNT(b.x)], 1u);
    return b;
}
__device__ __forceinline__ void xcd_barrier_complete(unsigned* bar, unsigned x, unsigned& nloc, unsigned& nx) {
    const unsigned G = gridDim.x * gridDim.y * gridDim.z;
    unsigned sum, cnt, mine, sp = 0u;
    for (;;) {
        sum = 0u; cnt = 0u; mine = 0u;
#pragma unroll
        for (unsigned j = 0; j < 16; ++j) { const unsigned c = xb_ld(&bar[XB_XCNT(j)]); sum += c; cnt += (c > 0u) ? 1u : 0u; mine = (j == x) ? c : mine; }
        if (sum == G) break;
        __builtin_amdgcn_s_sleep(1);
        if ((++sp & 255u) == 0u) { if (xb_ld(&bar[XB_TMO])) break; if (sp > XB_SPIN_CAP) { atomicAdd(&bar[XB_TMO], 1u); break; } }
    }
    nloc = mine > 0u ? mine : 1u; nx = cnt > 0u ? cnt : 1u;
}

__device__ __forceinline__ void xcd_barrier(const XcdBarrier& b) {
    asm volatile("s_waitcnt vmcnt(0)" ::: "memory");
    __syncthreads();
    if (threadIdx.x == 0) {
        unsigned* bar = b.bar;
        __builtin_amdgcn_s_waitcnt(0);
        unsigned nloc = b.st[0], nx = b.st[1];
        if (nloc == 0u) { xcd_barrier_complete(bar, b.x, nloc, nx); b.st[0] = nloc; b.st[1] = nx; }
        const unsigned old = xb_add(&bar[XB_XSUB(b.x)], 1u);
        const unsigned gen = old / nloc;
        if (old + 1u == (gen + 1u) * nloc) {
            __builtin_amdgcn_fence(__ATOMIC_RELEASE, "agent");
            asm volatile("s_waitcnt vmcnt(0)" ::: "memory");
            const unsigned og = xb_add(&bar[XB_TOP], 1u);
            const unsigned tg = og / nx;
            if (og + 1u == (tg + 1u) * nx) xb_add(&bar[XB_TOPGEN], 1u);
            else XB_SPIN(xb_ld(&bar[XB_TOPGEN]) == tg, bar);
            __builtin_amdgcn_fence(__ATOMIC_ACQUIRE, "agent");
            xb_add(&bar[XB_XGEN(b.x)], 1u);
            asm volatile("s_waitcnt vmcnt(0)" ::: "memory");
        } else {
            XB_SPIN(xb_ld(&bar[XB_XGEN(b.x)]) == gen, bar);
            __builtin_amdgcn_fence(__ATOMIC_ACQUIRE, "agent");
            asm volatile("s_waitcnt vmcnt(0)" ::: "memory");
        }
    }
    __syncthreads();
}


#define GAS __attribute__((address_space(1)))
#define WSL() ({ GAS unsigned char* w_ = (GAS unsigned char*)p.ws; asm volatile("" : "+s"(w_)); (unsigned char*)w_; })
#define INP(k) ({ int k_ = (k); asm volatile("" : "+s"(k_)); (const float*)(const GAS float*)p.in[k_]; })
#define POUT() ((float*)(GAS float*)p.out)
#define LN_PASS(GI, BI, WRITE_X) do { IDS(); unsigned char* ws_ = WSL(); float* X_ = POUT(); bf16_t* XN_ = (bf16_t*)(ws_ + A_XN); float* ST_ = (float*)(ws_ + WS_STATS); const float* gg = INP(GI) + layer * DM; const float* bb = INP(BI) + layer * DM; \
        f32x4 gvv[4], bvv[4];   \
        _Pragma("unroll") for (int jx = 0; jx < 4; ++jx) { gvv[jx] = *(const f32x4*)(gg + jx * 256 + lane * 4); bvv[jx] = *(const f32x4*)(bb + jx * 256 + lane * 4); } \
        for (int m_ = bx * 16 + wave * 2; m_ < M; m_ += G * 16) {   \
            f32x4 v[2][4]; float s[2] = {0.f, 0.f}; \
            _Pragma("unroll") for (int q = 0; q < 2; ++q) _Pragma("unroll") for (int jx = 0; jx < 4; ++jx) v[q][jx] = *(const f32x4*)(X_ + (size_t)(m_ + q) * DM + jx * 256 + lane * 4); \
            _Pragma("unroll") for (int q = 0; q < 2; ++q) { const int m = m_ + q; float* xr = X_ + (size_t)m * DM; \
            _Pragma("unroll") for (int jx = 0; jx < 4; ++jx) s[q] += (v[q][jx][0] + v[q][jx][1]) + (v[q][jx][2] + v[q][jx][3]); \
            s[q] = sum64(s[q]); \
            const float mean = s[q] * (1.f / DM); float s2 = 0.f; \
            _Pragma("unroll") for (int jx = 0; jx < 4; ++jx) { v[q][jx] = v[q][jx] - mean; s2 += (v[q][jx][0] * v[q][jx][0] + v[q][jx][1] * v[q][jx][1]) + (v[q][jx][2] * v[q][jx][2] + v[q][jx][3] * v[q][jx][3]); } \
            s2 = sum64(s2); \
            const float rstd = rsqrtf(s2 * (1.f / DM) + 1e-5f); \
            if (lane == 0) { ST_[(size_t)m * 2] = mean; ST_[(size_t)m * 2 + 1] = rstd; } \
            _Pragma("unroll") for (int jx = 0; jx < 4; ++jx) { const f32x4 gv = gvv[jx], bv = bvv[jx]; \
                const f32x4 y = v[q][jx] * rstd * gv + bv; if (WRITE_X) *(f32x4*)(xr + jx * 256 + lane * 4) = y; \
                if (!(WRITE_X)) { u32x2 w; w.x = pk2(y[0], y[1]); w.y = pk2(y[2], y[3]); *(u32x2*)(XN_ + (size_t)m * DM + jx * 256 + lane * 4) = w; } } } } } while (0)

__global__ void __launch_bounds__(512, 2) fwd_megakernel(Params p) {
    extern __shared__ __attribute__((aligned(16))) unsigned char lds_raw[];
    cg::grid_group grid = cg::this_grid();
    LAS unsigned char* lds = (LAS unsigned char*)lds_raw;
    LAS float* smf = (LAS float*)lds_raw;
    volatile LAS unsigned* bst = (volatile LAS unsigned*)(lds + 131072 + 512);
    if (threadIdx.x < 2) bst[threadIdx.x] = 0u;
    __syncthreads();
    (void)xcd_barrier_post((unsigned*)((unsigned char*)(GAS unsigned char*)p.ws + WS_SMALL + 65536), bst);
#define GSYNC() do { XcdBarrier xb_; xb_.bar = (unsigned*)(WSL() + WS_SMALL + 65536); xb_.x = xb_xcc_id(); xb_.st = (volatile LAS unsigned*)(lds + 131072 + 512); xcd_barrier(xb_); } while (0)
#define IDS() const int tid = ltid(), lane = tid & 63, wave = tid >> 6, bx = lbid(), G = lgdim(); (void)lane; (void)wave; (void)bx; (void)G; (void)tid

    if (PH(0)) {
        IDS(); unsigned char* ws = WSL();
        const float* x_in = (const float*)(const GAS float*)p.in[0];
        bf16_t* XN = (bf16_t*)(ws + A_XN);
        float* COS = (float*)(ws + WS_COS); float* SIN = (float*)(ws + WS_SIN);
        float* LBT = (float*)(ws + WS_SMALL); float* LAMV = (float*)(ws + WS_SMALL + 8192);
        LAS float* scr = smf + wave * (64 * 33);
        const int gw = bx * 8 + wave, NGW = G * 8;
        constexpr int I_IN = 16 * (DIN / 32), I_SQ = 16 * 32, I_UP = 16 * (2 * DFF / 32), I_DN = (DFF / 64) * 32, I_L = I_IN + 4 * I_SQ + I_UP + I_DN;
        for (int it = gw; it < 2 * I_L; it += NGW) {
            const int l = it / I_L; int r = it % I_L; bf16_t* wl = (bf16_t*)(ws + WS_W + (size_t)l * W_LAYER);
            if (r < I_IN) { p0_transpose_item<1>((const float*)(const GAS float*)p.in[3] + (size_t)l * DM * DIN, DM, DIN, (bf16_t*)((char*)wl + W_IN), scr, r, lane); continue; } r -= I_IN;
            if (r < I_SQ) { p0_transpose_item<0>((const float*)(const GAS float*)p.in[15] + (size_t)l * DM * DM, DM, DM, (bf16_t*)((char*)wl + W_OUT), scr, r, lane); continue; } r -= I_SQ;
            if (r < I_SQ) { p0_transpose_item<0>((const float*)(const GAS float*)p.in[19] + (size_t)l * DM * DM, DM, DM, (bf16_t*)((char*)wl + W_K), scr, r, lane); continue; } r -= I_SQ;
            if (r < I_SQ) { p0_transpose_item<0>((const float*)(const GAS float*)p.in[20] + (size_t)l * DM * DM, DM, DM, (bf16_t*)((char*)wl + W_V), scr, r, lane); continue; } r -= I_SQ;
            if (r < I_SQ) { p0_transpose_item<0>((const float*)(const GAS float*)p.in[21] + (size_t)l * DM * DM, DM, DM, (bf16_t*)((char*)wl + W_O), scr, r, lane); continue; } r -= I_SQ;
            if (r < I_UP) { p0_transpose_item<2>((const float*)(const GAS float*)p.in[24] + (size_t)l * DM * 2 * DFF, DM, 2 * DFF, (bf16_t*)((char*)wl + W_UP), scr, r, lane); continue; } r -= I_UP;
            p0_transpose_item<0>((const float*)(const GAS float*)p.in[27] + (size_t)l * DFF * DM, DFF, DM, (bf16_t*)((char*)wl + W_DN), scr, r, lane);
        }
        const size_t gt = (size_t)bx * 512 + tid, NT = (size_t)G * 512;
        for (size_t i = gt; i < (size_t)M * DM / 8; i += 4 * NT) { f32x4 a[4], b[4];
#pragma unroll
            for (int q = 0; q < 4; ++q) { a[q] = *(const f32x4*)(x_in + (i + q * NT) * 8); b[q] = *(const f32x4*)(x_in + (i + q * NT) * 8 + 4); }
#pragma unroll
            for (int q = 0; q < 4; ++q) { u32x4 w; w.x = pk2(a[q][0], a[q][1]); w.y = pk2(a[q][2], a[q][3]); w.z = pk2(b[q][0], b[q][1]); w.w = pk2(b[q][2], b[q][3]); *(u32x4*)(XN + (i + q * NT) * 8) = w; } }
        { const float* mem = (const float*)(const GAS float*)p.in[1]; bf16_t* MEMB = (bf16_t*)(ws + A_MEMB);
          for (size_t i = gt; i < (size_t)BATCH * NMEM * DM / 8; i += NT) { const f32x4 a = *(const f32x4*)(mem + i * 8), b = *(const f32x4*)(mem + i * 8 + 4);
              u32x4 w; w.x = pk2(a[0], a[1]); w.y = pk2(a[2], a[3]); w.z = pk2(b[0], b[1]); w.w = pk2(b[2], b[3]); *(u32x4*)(MEMB + i * 8) = w; } }
        for (size_t i = gt; i < (size_t)2 * DM * DM / 8; i += NT) { const int l = (int)(i / (DM * DM / 8)); const size_t r = i % (DM * DM / 8);
            const float* src = (const float*)(const GAS float*)p.in[18] + (size_t)l * DM * DM + r * 8; bf16_t* dst = (bf16_t*)(ws + WS_W + (size_t)l * W_LAYER + W_Q) + r * 8;
            const f32x4 a = *(const f32x4*)src, b = *(const f32x4*)(src + 4);
            u32x4 w; w.x = pk2(a[0], a[1]); w.y = pk2(a[2], a[3]); w.z = pk2(b[0], b[1]); w.w = pk2(b[2], b[3]); *(u32x4*)dst = w; }
        { const int* pos = (const int*)(const GAS int*)p.in[2];
          for (size_t i = gt; i < (size_t)M * 32; i += NT) { const int tok = (int)(i >> 5), fi = (int)(i & 31);
              const double inv = exp(-(double)fi * (9.210340371976184 / 32.0)); const double ang = (double)pos[tok] * inv;
              const double k = rint(ang * 0.15915494309189535); double r = fma(-k, 6.283185307179586, ang); r = fma(-k, 2.4492935982947064e-16, r);
              const float rf = (float)r; COS[i] = cosf(rf); SIN[i] = sinf(rf); } }
        { bf16_t* RGW = (bf16_t*)(ws + WS_RGW); const float* wa = (const float*)(const GAS float*)p.in[8]; const float* wx = (const float*)(const GAS float*)p.in[10];
          for (size_t i = gt; i < (size_t)2 * 4 * 4 * 4096; i += NT) { const int ii = (int)(i & 63), jj = (int)((i >> 6) & 63), g = (int)((i >> 12) & 3), n = (int)((i >> 14) & 3), l = (int)(i >> 16);
              const float* src = (g < 2 ? wa : wx) + ((size_t)((l * 2 + (g & 1)) * 4 + n)) * 4096 + ii * 64 + jj; RGW[i] = (bf16_t)f2bf(*src); } }
        if (bx == 0) {
            const float* hlb = (const float*)(const GAS float*)p.in[4];
            for (int i = tid; i < 512; i += 512) { const float e0 = __expf(hlb[i]), e1 = __expf(hlb[512 + i]); LBT[i] = 0.f; LBT[512 + i] = e1 / (e0 + e1); }
            if (tid < 2) { const float* lp = (const float*)(const GAS float*)p.in[13] + tid * 256; float s1 = 0.f, s2 = 0.f; for (int k = 0; k < 64; ++k) { s1 += lp[k] * lp[64 + k]; s2 += lp[128 + k] * lp[192 + k]; }
                LAMV[tid] = expf(s1) - expf(s2) + (0.8f - 0.6f * expf(-0.3f * (float)tid)); }
        }
    }
    grid.sync();
    if (PH(1) && lbid() < 32) {
        IDS(); unsigned char* ws = WSL();
        const int ci = bx >> 3, l = ci >> 1, kv = ci & 1;
        pg8::Gemm g{(const bf16_t*)(ws + A_MEMB), (const bf16_t*)(ws + WS_W + (size_t)l * W_LAYER + (kv ? W_V : W_K)), 512, DM, DM, DM, DM, 1 << 30, 0};
        pg8::StaticOrder S; S.init(512, DM, 8, bx & 7);
        pg8::EpiRow8<FStore> E{{(bf16_t*)(ws + (kv ? A_VMEM : A_KMEM) + (size_t)l * MiB), DM}};
        pg8::gemm_phase(lds, g, S, E);
    }
    GSYNC();
    if (PH(2) && lbid() < 128) {
        IDS(); unsigned char* ws = WSL();
        const int ci = bx >> 2, which = ci >> 4, l = (ci >> 3) & 1, b = (ci >> 2) & 1, h = ci & 3;
        const bf16_t* wl = (const bf16_t*)(ws + WS_W + (size_t)l * W_LAYER);
        pg8::Gemm g; pg8::StaticOrder S; bf16_t* O;
        if (which == 0) {
            g = pg8::Gemm{(const bf16_t*)(ws + A_KMEM + (size_t)l * MiB) + (size_t)b * 256 * DM + h * 256, (const bf16_t*)((const char*)wl + W_Q) + h * 256, 256, DM, 256, DM, DM, 1 << 30, 0};
            S.init(256, DM, 4, bx & 3);
            O = (bf16_t*)(ws + WS_GB) + ((size_t)(l * 2 + b) * DM + h * 256) * DM;
        } else {
            g = pg8::Gemm{(const bf16_t*)((const char*)wl + W_O) + h * 256, (const bf16_t*)(ws + A_VMEM + (size_t)l * MiB) + (size_t)b * 256 * DM + h * 256, DM, 256, 256, DM, DM, 1 << 30, 0};
            S.init(DM, 256, 4, bx & 3);
            O = (bf16_t*)(ws + WS_BT2) + (size_t)(l * 2 + b) * DM * DM + h * 256;
        }
        pg8::EpiRow8<FStore> E{{O, DM}};
        pg8::gemm_phase(lds, g, S, E);
    }
    GSYNC();

#pragma unroll 1
    for (int layer = 0; layer < DEPTH; ++layer) {
        _Pragma("unroll 1") for (int rep_ = REPS(3); rep_ > 0; --rep_) if (PH(3)) {
            IDS(); unsigned char* ws = WSL();
            pg8::Gemm g{(const bf16_t*)(ws + A_XN), (const bf16_t*)(ws + WS_W + (size_t)layer * W_LAYER + W_IN), M, DIN, DM, DM, DM, 1 << 30, 0};
            pg8::StaticOrder S; S.init(M, DIN, G, bx);
            pg8::EpiRow8<FProj> E{{(bf16_t*)(ws + A_HQ), (bf16_t*)(ws + A_HI), (bf16_t*)(ws + A_HG), (bf16_t*)(ws + A_RY), (bf16_t*)(ws + A_DQ), (bf16_t*)(ws + A_DK), (bf16_t*)(ws + A_DV),
                                   (float*)(ws + A_ZF0), (float*)(ws + A_ZF1), (float*)(ws + A_RX), (const float*)(ws + WS_COS), (const float*)(ws + WS_SIN)}};
            pg8::gemm_phase(lds, g, S, E);
        }
        GSYNC();
        if (PH(4)) {
            IDS();
            { unsigned char* ws = WSL(); const float* lbt = (const float*)(ws + WS_SMALL) + layer * 512;
              _Pragma("unroll 1") for (int rep_ = REPS(4); rep_ > 0; --rep_) hg::phase_a(smf, bx, G, (const float*)(ws + A_ZF0), (const float*)(ws + A_ZF1), (const bf16_t*)(ws + A_HI), lbt, (float*)(ws + A_ST), (float*)(ws + A_HD)); }
            { unsigned char* ws = WSL();
              _Pragma("unroll 1") for (int rep_ = REPS(12); rep_ > 0; --rep_) rg::phase_rg<false>(lds, bx, G, (const float*)(ws + A_RX), (const bf16_t*)(ws + A_RY), INP(6) + layer * 1024, INP(7) + layer * 256, (const bf16_t*)(ws + WS_RGW) + (size_t)layer * 65536, INP(9) + layer * 512,
                                INP(11) + layer * 512, INP(12) + layer * 512, (float*)(ws + A_RGAGG), (const float*)(ws + A_RGCAR), (bf16_t*)(ws + A_XN)); }
        }
        GSYNC();
        { IDS(); unsigned char* ws = WSL();
          hg::phase_b((float*)(ws + A_ST), (const float*)(ws + A_HD));
          if (bx >= 128 && bx < 130) {
            const float* AGG = (const float*)(ws + A_RGAGG); float* CAR = (float*)(ws + A_RGCAR);
            const int gid = (bx - 128) * 512 + tid; const int ch = gid & 255, dir = (gid >> 8) & 1, b = gid >> 9;
            const size_t base = (size_t)((b * 2 + dir) * 128) * 256 + ch; float h = 0.f;
            typedef float f32x2 __attribute__((ext_vector_type(2)));
#pragma unroll 1
            for (int q0 = 0; q0 < 128; q0 += 16) { f32x2 ab[16];
#pragma unroll
                for (int i = 0; i < 16; ++i) { const int c = dir ? 127 - (q0 + i) : q0 + i; ab[i] = *(const f32x2*)(AGG + (base + (size_t)c * 256) * 2); }
#pragma unroll
                for (int i = 0; i < 16; ++i) { const int c = dir ? 127 - (q0 + i) : q0 + i; CAR[base + (size_t)c * 256] = h; h = ab[i][0] * h + ab[i][1]; } }
          } }
        GSYNC();
        if (PH(5)) {
            IDS();
            { unsigned char* ws = WSL(); const float* lbt = (const float*)(ws + WS_SMALL) + layer * 512;
              _Pragma("unroll 1") for (int rep_ = REPS(5); rep_ > 0; --rep_) hg::phase_c(smf, bx, G, (const float*)(ws + A_ZF0), (const float*)(ws + A_ZF1), (const bf16_t*)(ws + A_HQ), (const bf16_t*)(ws + A_HI), (const bf16_t*)(ws + A_HG), lbt,
                                                            (const float*)(ws + A_ST), INP(5) + layer * 256, (bf16_t*)(ws + A_XN)); }
            { unsigned char* ws = WSL();
              _Pragma("unroll 1") for (int rep_ = REPS(13); rep_ > 0; --rep_) rg::phase_rg<true>(lds, bx, G, (const float*)(ws + A_RX), (const bf16_t*)(ws + A_RY), INP(6) + layer * 1024, INP(7) + layer * 256, (const bf16_t*)(ws + WS_RGW) + (size_t)layer * 65536, INP(9) + layer * 512,
                               INP(11) + layer * 512, INP(12) + layer * 512, (float*)(ws + A_RGAGG), (const float*)(ws + A_RGCAR), (bf16_t*)(ws + A_XN)); }
        }
        _Pragma("unroll 1") for (int rep_ = REPS(6); rep_ > 0; --rep_) if (PH(6)) {
            IDS(); unsigned char* ws = WSL();
            const bf16_t* DQ = (const bf16_t*)(ws + A_DQ); const bf16_t* DK = (const bf16_t*)(ws + A_DK); const bf16_t* DV = (const bf16_t*)(ws + A_DV); bf16_t* MIX = (bf16_t*)(ws + A_XN);
            const float lam = ((const float*)(ws + WS_SMALL + 8192))[layer]; const float gscale = 1.f - (0.8f - 0.6f * expf(-0.3f * (float)layer));
            float* scratch = (float*)(ws + A_MIX_END) + (size_t)bx * 256 * 128;
            const float* subg = INP(14) + layer * 128;
            const int vcu = (G % 8 == 0) ? (bx % 8) * (G / 8) + bx / 8 : bx;
            for (int pr = vcu; pr < 512; pr += G) {
                const int bh = pr >> 6, qb = pr & 63, b = bh >> 2, h = bh & 3;
                const size_t row0 = (size_t)b * SEQ;
#pragma unroll 1
                for (int c = 0; c < 2; ++c) {
                    att::attn_unit(DQ + (row0 + qb * 256) * 512 + (h * 2 + c) * 64, DK + row0 * 512 + (h * 2 + c) * 64, DV + row0 * 512 + h * 128, SEQ, (char*)lds_raw,
                                   c, scratch, lam, gscale, subg, MIX + (row0 + qb * 256) * 1024 + 512 + h * 128);
                }
            }
        }
        GSYNC();
        if (PH(7)) {
            IDS(); unsigned char* ws = WSL();
            pg8::Gemm g{(const bf16_t*)(ws + A_XN), (const bf16_t*)(ws + WS_W + (size_t)layer * W_LAYER + W_OUT), M, DM, DM, DM, DM, 1 << 30, 0};
            pg8::StaticOrder S; S.init(M, DM, G, bx);
            EpiRes E{(layer == 0) ? (const float*)(const GAS float*)p.in[0] : (const float*)POUT(), POUT(), (layer == 0) ? (const float*)nullptr : (const float*)(ws + WS_STATS), INP(28) + (layer - 1) * DM, INP(29) + (layer - 1) * DM};
            pg8::gemm_phase(lds, g, S, E);
        }
        GSYNC();
        LN_PASS(16, 17, false);
        GSYNC();
        _Pragma("unroll 1") for (int rep_ = REPS(8); rep_ > 0; --rep_) if (PH(8)) {
            IDS(); unsigned char* ws = WSL();
            pg8::Gemm g{(const bf16_t*)(ws + A_XN), (const bf16_t*)(ws + WS_GB) + (size_t)layer * 2 * DM * DM, M, DM, DM, DM, DM, 64, (size_t)DM * DM};
            pg8::StaticOrder S; S.init(M, DM, G, bx);
            pg8::EpiRow8<FScores> E{{(bf16_t*)(ws + A_P), (float*)(ws + A_LSUM)}};
            pg8::gemm_phase(lds, g, S, E);
        }
        GSYNC();
        { IDS(); unsigned char* ws = WSL(); bf16_t* PB = (bf16_t*)(ws + A_P); const float* LS = (const float*)(ws + A_LSUM);
          const size_t NTH = (size_t)G * 512;
          for (size_t i0 = (size_t)bx * 512 + tid; i0 < (size_t)M * DM / 8; i0 += 2 * NTH) {
            f32x4 a[2], b[2]; u32x4 pw[2];
#pragma unroll
            for (int q = 0; q < 2; ++q) { const size_t i = i0 + q * NTH; const size_t row = i >> 7; const int c8 = (int)(i & 127) * 8, hd = c8 >> 8; const float* lp = LS + row * 32 + hd * 8;
                a[q] = *(const f32x4*)lp; b[q] = *(const f32x4*)(lp + 4); pw[q] = *(const u32x4*)(PB + i * 8); }
#pragma unroll
            for (int q = 0; q < 2; ++q) { const size_t i = i0 + q * NTH; const float inv = __builtin_amdgcn_rcpf(((a[q][0] + a[q][1]) + (a[q][2] + a[q][3])) + ((b[q][0] + b[q][1]) + (b[q][2] + b[q][3])));
                float v[8]; unpack8(pw[q], v);
#pragma unroll
                for (int e = 0; e < 8; ++e) v[e] *= inv;
                st8_bf16(PB + i * 8, v); }
          } }
        GSYNC();
        if (PH(9)) {
            IDS(); unsigned char* ws = WSL();
            pg8::Gemm g{(const bf16_t*)(ws + A_P), (const bf16_t*)(ws + WS_BT2) + (size_t)layer * 2 * DM * DM, M, DM, DM, DM, DM, 64, (size_t)DM * DM};
            pg8::StaticOrder S; S.init(M, DM, G, bx);
            EpiRes E{(const float*)POUT(), POUT(), (const float*)(ws + WS_STATS), INP(16) + layer * DM, INP(17) + layer * DM};
            pg8::gemm_phase(lds, g, S, E);
        }
        GSYNC();
        LN_PASS(22, 23, false);
        GSYNC();
        _Pragma("unroll 1") for (int rep_ = REPS(10); rep_ > 0; --rep_) if (PH(10)) {
            IDS(); unsigned char* ws = WSL();
            pg8::Gemm g{(const bf16_t*)(ws + A_XN), (const bf16_t*)(ws + WS_W + (size_t)layer * W_LAYER + W_UP), M, 2 * DFF, DM, DM, DM, 1 << 30, 0};
            pg8::StaticOrder S; S.init(M, 2 * DFF, G, bx);
            EpiUpConv E{(bf16_t*)(ws + A_VAL), (float*)(ws + A_GATE), INP(25) + (size_t)layer * 3 * DFF, INP(26) + (size_t)layer * DFF};
            pg8::gemm_phase<EpiUpConv, true>(lds, g, S, E);
        }
        GSYNC();
        {
            IDS(); unsigned char* ws = WSL(); bf16_t* H = (bf16_t*)(ws + A_VAL); const float* SB = (const float*)(ws + A_GATE);
            const float* cw = INP(25) + (size_t)layer * 3 * DFF;
            const size_t PL_ = 256 * (size_t)DFF;
            for (size_t i = (size_t)bx * 512 + tid; i < (size_t)2 * 256 * DFF; i += (size_t)G * 512) {
                const int side = (int)(i / (256 * (size_t)DFF)); const size_t r = i % (256 * (size_t)DFF); const int grp = (int)(r / DFF), c = (int)(r % DFF);
                float part, val, nb; size_t tok;
                if (side == 0) { part = SB[0 * PL_ + r]; val = SB[1 * PL_ + r]; nb = ((grp & 127) == 0) ? 0.f : SB[5 * PL_ + (size_t)(grp - 1) * DFF + c]; part += cw[c] * nb; tok = (size_t)grp * 128; }
                else { part = SB[3 * PL_ + r]; val = SB[4 * PL_ + r]; nb = ((grp & 127) == 127) ? 0.f : SB[2 * PL_ + (size_t)(grp + 1) * DFF + c]; part += cw[2 * DFF + c] * nb; tok = (size_t)grp * 128 + 127; }
                H[tok * DFF + c] = (bf16_t)f2bf(gelu_tanh(part) * val);
            }
        }
        GSYNC();
        if (PH(11)) {
            IDS(); unsigned char* ws = WSL();
            pg8::Gemm g{(const bf16_t*)(ws + A_VAL), (const bf16_t*)(ws + WS_W + (size_t)layer * W_LAYER + W_DN), M, DM, DFF, DFF, DFF, 1 << 30, 0};
            pg8::StaticOrder S; S.init(M, DM, G, bx);
            EpiRes E{(const float*)POUT(), POUT(), (const float*)(ws + WS_STATS), INP(22) + layer * DM, INP(23) + layer * DM};
            pg8::gemm_phase(lds, g, S, E);
        }
        GSYNC();
        LN_PASS(28, 29, (layer == DEPTH - 1));
        GSYNC();
    }
}

extern "C" void kernel_launch(void* const* d_in, const int* in_sizes, int n_in, void* d_out, int out_size, void* d_ws, size_t ws_size, hipStream_t stream) {
    static int grid_blocks = 0;
    if (grid_blocks == 0) {
        if (n_in != 30 || out_size != M * DM || ws_size < WS_END) { fprintf(stderr, "kernel_launch: unexpected shapes (n_in %d out %d ws %zu, need ws >= %zu)\n", n_in, out_size, ws_size, (size_t)WS_END); grid_blocks = -1; return; }
        int dev = 0, cus = 0, per_cu = 0;
        hipGetDevice(&dev); hipDeviceGetAttribute(&cus, hipDeviceAttributeMultiprocessorCount, dev);
        if (hipFuncSetAttribute((const void*)fwd_megakernel, hipFuncAttributeMaxDynamicSharedMemorySize, LDS_BYTES) != hipSuccess) { fprintf(stderr, "kernel_launch: hipFuncSetAttribute failed\n"); grid_blocks = -1; return; }
        hipOccupancyMaxActiveBlocksPerMultiprocessor(&per_cu, (const void*)fwd_megakernel, 512, LDS_BYTES);
        if (per_cu < 1) { fprintf(stderr, "kernel_launch: occupancy query says %d\n", per_cu); per_cu = 1; }
        grid_blocks = cus * 1;
        (void)hipGetLastError();
    }
    if (grid_blocks < 0) return;
    if (hipMemsetAsync((char*)d_ws + WS_SMALL + 65536, 0, 16384, stream) != hipSuccess) { fprintf(stderr, "kernel_launch: memset failed\n"); return; }
    Params p{};
    for (int i = 0; i < 30; ++i) p.in[i] = d_in[i];
    p.out = (float*)d_out; p.ws = (unsigned char*)d_ws;
    void* args[] = {&p};
    hipError_t e = hipLaunchCooperativeKernel((const void*)fwd_megakernel, dim3(grid_blocks), dim3(512), args, LDS_BYTES, stream);
    if (e != hipSuccess) fprintf(stderr, "cooperative launch failed: %s (grid %d)\n", hipGetErrorString(e), grid_blocks);
}
```

```cpp
#include <hip/hip_runtime.h>
#include <hip/hip_cooperative_groups.h>
#include <cstdio>
#include <cstdint>
namespace cg = cooperative_groups;

#define LAS __attribute__((address_space(3)))
typedef unsigned short bf16_t;
typedef short bf16x8 __attribute__((ext_vector_type(8)));
typedef short s16x4 __attribute__((ext_vector_type(4)));
typedef float f32x4 __attribute__((ext_vector_type(4)));
typedef float f32x16 __attribute__((ext_vector_type(16)));
typedef unsigned u32x4 __attribute__((ext_vector_type(4)));
typedef unsigned u32x2 __attribute__((ext_vector_type(2)));

constexpr int BATCH = 2, SEQ = 16384, DM = 1024, DEPTH = 2, M = BATCH * SEQ, DIN = 3328, DFF = 2816, NMEM = 256;
constexpr float ALPHA = 1.4142135623730951f;
constexpr size_t MiB = 1u << 20;
constexpr size_t WS_COS = 0, WS_SIN = 4 * MiB, WS_SMALL = 8 * MiB;
constexpr size_t WS_RGW = 8 * MiB + 131072;
constexpr size_t WS_STATS = 8 * MiB + 524288;
constexpr size_t WS_GB = 9 * MiB;
constexpr size_t WS_BT2 = 17 * MiB;
constexpr size_t WS_W = 25 * MiB;
constexpr size_t W_IN = 0, W_OUT = 13 * MiB / 2, W_Q = W_OUT + 2 * MiB, W_K = W_Q + 2 * MiB, W_V = W_K + 2 * MiB, W_O = W_V + 2 * MiB, W_UP = W_O + 2 * MiB, W_DN = W_UP + 11 * MiB, W_LAYER = W_DN + 11 * MiB / 2;
static_assert(W_LAYER == 33 * MiB && WS_W + 2 * W_LAYER <= 92 * MiB, "weights per layer");
constexpr size_t WS_ARENA = 92 * MiB;
constexpr size_t A_XN = WS_ARENA;
constexpr size_t A_HQ = WS_ARENA + 64 * MiB, A_HI = A_HQ + 16 * MiB, A_HG = A_HI + 16 * MiB, A_RY = A_HG + 16 * MiB;
constexpr size_t A_ZF0 = A_RY + 16 * MiB, A_ZF1 = A_ZF0 + 32 * MiB, A_RX = A_ZF1 + 32 * MiB;
constexpr size_t A_DQ = A_RX + 32 * MiB, A_DK = A_DQ + 32 * MiB, A_DV = A_DK + 32 * MiB;
constexpr size_t A_ST = A_DV + 32 * MiB;
constexpr size_t A_RGAGG = A_ST + 64 * MiB, A_RGCAR = A_RGAGG + 1 * MiB, A_HD = A_RGCAR + 1 * MiB, A_MIX_END = A_HD + 1 * MiB;
constexpr size_t A_P = WS_ARENA + 64 * MiB, A_LSUM = A_P + 64 * MiB;
constexpr size_t A_MEMB = A_LSUM + 4 * MiB, A_KMEM = A_MEMB + 1 * MiB, A_VMEM = A_KMEM + 2 * MiB;
constexpr size_t A_GATE = WS_ARENA + 64 * MiB, A_VAL = A_GATE + 176 * MiB, WS_END = A_VAL + 176 * MiB;
static_assert(WS_END <= 512 * MiB && A_MIX_END + 32 * MiB <= 512 * MiB, "workspace map");

constexpr int LDS_BYTES = 132096;
#ifndef PHMASK
#define PHMASK 0xFFFFFFFFu
#endif
#define PH(k) ((PHMASK >> (k)) & 1u)
#ifndef REPMASK
#define REPMASK 0u
#endif
#define REPS(k) ({ int r_ = 1 + (int)((REPMASK >> (k)) & 1u); asm volatile("" : "+s"(r_)); r_; })

struct Params { const void* in[30]; float* out; unsigned char* ws; };

__device__ __forceinline__ int ltid() { int t = threadIdx.x; asm volatile("" : "+v"(t)); return t; }
__device__ __forceinline__ int lbid() { int t = blockIdx.x; asm volatile("" : "+s"(t)); return t; }
__device__ __forceinline__ int lgdim() { int t = gridDim.x; asm volatile("" : "+s"(t)); return t; }
typedef float f32x2_cv __attribute__((ext_vector_type(2))); typedef __bf16 bf16x2_cv __attribute__((ext_vector_type(2)));
__device__ __forceinline__ unsigned pk2(float lo, float hi) { const f32x2_cv v = {lo, hi}; return __builtin_bit_cast(unsigned, __builtin_convertvector(v, bf16x2_cv)); }
__device__ __forceinline__ unsigned f2bf(float f) { return pk2(f, 0.f) & 0xffffu; }
__device__ __forceinline__ float bf2f(unsigned h) { return __builtin_bit_cast(float, h << 16); }
__device__ __forceinline__ float bflo(unsigned w) { return __builtin_bit_cast(float, w << 16); }
__device__ __forceinline__ float bfhi(unsigned w) { return __builtin_bit_cast(float, w & 0xffff0000u); }
__device__ __forceinline__ unsigned cvt_pk_bf16(float lo, float hi) { unsigned r; asm volatile("v_cvt_pk_bf16_f32 %0, %1, %2" : "=v"(r) : "v"(lo), "v"(hi)); return r; }
template <int CTRL> __device__ __forceinline__ float dppf(float v) { return __builtin_bit_cast(float, __builtin_amdgcn_update_dpp(0, __builtin_bit_cast(int, v), CTRL, 0xF, 0xF, true)); }
__device__ __forceinline__ float swap16_sum(float v) { auto r = __builtin_amdgcn_permlane16_swap(__float_as_uint(v), __float_as_uint(v), false, false); return __uint_as_float(r[0]) + __uint_as_float(r[1]); }
__device__ __forceinline__ float swap32_sum(float v) { auto r = __builtin_amdgcn_permlane32_swap(__float_as_uint(v), __float_as_uint(v), false, false); return __uint_as_float(r[0]) + __uint_as_float(r[1]); }
__device__ __forceinline__ float sum8(float v) { v += dppf<0xB1>(v); v += dppf<0x4E>(v); v += dppf<0x141>(v); return v; }
__device__ __forceinline__ float sum16(float v) { v = sum8(v); v += dppf<0x140>(v); return v; }
__device__ __forceinline__ float sum32(float v) { return swap16_sum(sum16(v)); }
__device__ __forceinline__ float sum64(float v) { return swap32_sum(sum32(v)); }
__device__ __forceinline__ float sigm(float x) { return __builtin_amdgcn_rcpf(1.f + __expf(-x)); }
__device__ __forceinline__ float siluf(float x) { return x * sigm(x); }
__device__ __forceinline__ float nexpm1(float x) { const float p = -x * (1.f + x * (0.5f + x * (0.16666667f + x * (0.041666668f + x * (0.0083333338f + x * 0.0013888889f))))); return x > -0.5f ? p : 1.f - __expf(x); }
__device__ __forceinline__ float gelu_tanh(float x) { const float t = x * (-2.3022082f + -0.10294324f * (x * x)); return x * __builtin_amdgcn_rcpf(1.f + __builtin_amdgcn_exp2f(t)); }
__device__ __forceinline__ u32x4 pack8(const float* v) { u32x4 w; w.x = cvt_pk_bf16(v[0], v[1]); w.y = cvt_pk_bf16(v[2], v[3]); w.z = cvt_pk_bf16(v[4], v[5]); w.w = cvt_pk_bf16(v[6], v[7]); return w; }
__device__ __forceinline__ void unpack8(u32x4 w, float* v) { v[0] = bflo(w.x); v[1] = bfhi(w.x); v[2] = bflo(w.y); v[3] = bfhi(w.y); v[4] = bflo(w.z); v[5] = bfhi(w.z); v[6] = bflo(w.w); v[7] = bfhi(w.w); }

namespace pg8 {
constexpr int BM = 256, BK = 64, HALF = 128, HTB = HALF * BK * 2, STAGE_BYTES = 8 * HTB, NXCD = 8, WGM = 8;
__host__ __device__ __forceinline__ int lds_byte(int r, int c) { const int st = (r >> 4) * 2 + (c >> 5), rr = r & 15, cc = c & 31, ob = rr * 64 + cc * 2; return st * 1024 + (ob ^ (((ob >> 9) & 1) << 5)); }
__host__ __device__ __forceinline__ void stage_rc(int b, int& R, int& C) { const int st = b / 1024, sb = b % 1024, swz = sb ^ (((sb >> 9) & 1) << 5); R = (st >> 1) * 16 + swz / 64; C = (st & 1) * 32 + (swz % 64) / 2; }
__host__ __device__ __forceinline__ int perm32(int rho) { const int n = rho >> 4, i = rho & 15; return 8 * (i >> 2) + 4 * n + (i & 3); }
struct Unit { int pm, pn; };
struct Gemm { const bf16_t* A; const bf16_t* Bt; int M, N, K, lda, ldb; int pm_per_batch; size_t b_batch_stride; };
struct StaticOrder {
    int nM, nN, nwg, G, c;
    __device__ void init(int M_, int N_, int G_, int c_) { nM = M_ / BM; nN = N_ / BM; nwg = nM * nN; G = G_; c = c_; }
    __device__ bool next(int i, Unit& u) const {
        const long L = (long)i * G + c; if (L >= nwg) return false;
        int wgid = (int)L; { const int q = nwg / NXCD, r = nwg % NXCD, xcd = wgid % NXCD, off = wgid / NXCD; wgid = (xcd < r ? xcd * (q + 1) : r * (q + 1) + (xcd - r) * q) + off; }
        const int nig = WGM * nN, gid = wgid / nig, fm = gid * WGM, gsz = (nM - fm) < WGM ? (nM - fm) : WGM;
        u.pm = fm + ((wgid % nig) % gsz); u.pn = (wgid % nig) / gsz; return true;
    }
};
template <class F> struct EpiRow8 {
    F f;
    __device__ __forceinline__ void operator()(const f32x4 (&acc)[2][2][4][2], const Unit& u, int wr, int wc, int fr, int fq) const {
        const int row0 = u.pm * BM + wr * 64 + fr, colb = u.pn * BM + wc * 32 + 8 * fq;
#pragma unroll
        for (int ai = 0; ai < 2; ++ai)
#pragma unroll
            for (int m = 0; m < 4; ++m)
            {
#pragma unroll
              for (int bj = 0; bj < 2; ++bj) f(row0 + ai * HALF + m * 16, colb + bj * HALF, acc[ai][bj][m][0], acc[ai][bj][m][1]);
              asm volatile("" ::: "memory"); }
    }
};

template <class Epi, bool APERM = false>
__device__ __forceinline__ void gemm_phase(LAS unsigned char* lds, const Gemm g, const StaticOrder& S, const Epi& E) {
    int tid_ = threadIdx.x; asm volatile("" : "+v"(tid_));
    const int tid = tid_, wid = __builtin_amdgcn_readfirstlane(tid >> 6), lane = tid & 63, wr = wid >> 2, wc = wid & 3, fr = lane & 15, fq = lane >> 4;
    const int K = g.K, nt = K / BK;
    unsigned voffA[2], voffB[2];
#pragma unroll
    for (int i = 0; i < 2; ++i) { int R, C; stage_rc(tid * 16 + i * 8192, R, C); const int Rb = (R & ~31) + perm32(R & 31);
        const int Ra = APERM ? (128 * (R >> 6) + 8 * (R & 15) + ((R >> 4) & 3)) : R;
        voffA[i] = (unsigned)(Ra * g.lda + C) * 2u; voffB[i] = (unsigned)(Rb * g.ldb + C) * 2u; }
    const size_t kstep = (size_t)(BK * 2);
    const size_t hstepA = (size_t)(APERM ? 4 : HALF) * g.lda * 2, hstepB = (size_t)HALF * g.ldb * 2;
    const size_t tstepA = (size_t)BM * g.lda * 2, tstepB = 2 * hstepB;
    const unsigned ldsw = (unsigned)wid * 1024u;
    const int aoff = lds_byte(wr * 64 + fr, fq * 8), boff = lds_byte(wc * 32 + fr, fq * 8);
#define PG8_SA(b, h) (((b) * 2 + (h)) * HTB)
#define PG8_SB(b, h) ((4 + (b) * 2 + (h)) * HTB)
#define PG8_STAGE(bufoff, gbase, voff) do { _Pragma("unroll") for (int _i = 0; _i < 2; ++_i) \
        __builtin_amdgcn_global_load_lds((const unsigned*)((const char*)(gbase) + (voff)[_i]), (LAS unsigned*)(lds + (bufoff) + ldsw + _i * 8192), 16, 0, 0); } while (0)
#define PG8_LDA(dst, b, h) do { _Pragma("unroll") for (int m = 0; m < 4; ++m) _Pragma("unroll") for (int k = 0; k < 2; ++k) dst[m][k] = *(const LAS bf16x8*)(lds + PG8_SA(b, h) + aoff + m * 2048 + k * 1024); } while (0)
#define PG8_LDB(dst, b, h) do { _Pragma("unroll") for (int n = 0; n < 2; ++n) _Pragma("unroll") for (int k = 0; k < 2; ++k) dst[n][k] = *(const LAS bf16x8*)(lds + PG8_SB(b, h) + boff + n * 2048 + k * 1024); } while (0)
#define PG8_MMA(ai, bj, At, Bt) do { __builtin_amdgcn_s_setprio(1); _Pragma("unroll") for (int m = 0; m < 4; ++m) _Pragma("unroll") for (int n = 0; n < 2; ++n) _Pragma("unroll") for (int k = 0; k < 2; ++k) \
        acc[ai][bj][m][n] = __builtin_amdgcn_mfma_f32_16x16x32_bf16(Bt[n][k], At[m][k], acc[ai][bj][m][n], 0, 0, 0); __builtin_amdgcn_s_setprio(0); } while (0)
#define PG8_WAIT_V(n) asm volatile("s_waitcnt vmcnt(" #n ")" ::: "memory")
#define PG8_WAIT_L(n) asm volatile("s_waitcnt lgkmcnt(" #n ")" ::: "memory")
#define PG8_BAR __builtin_amdgcn_s_barrier()
#define PG8_SCHED __builtin_amdgcn_sched_barrier(0)
    Unit cur, nxt; int ui = 0;
    if (!S.next(0, cur)) return;
    f32x4 acc[2][2][4][2];
#pragma unroll
    for (int a = 0; a < 2; ++a)
#pragma unroll
        for (int b = 0; b < 2; ++b)
#pragma unroll
            for (int m = 0; m < 4; ++m)
#pragma unroll
                for (int n = 0; n < 2; ++n) acc[a][b][m][n] = (f32x4){0.f, 0.f, 0.f, 0.f};
    bf16x8 At[4][2], B0[2][2], B1[2][2];
    const char* cA = (const char*)g.A + (size_t)cur.pm * tstepA;
    const char* cB = (const char*)g.Bt + (size_t)cur.pn * tstepB + (size_t)(cur.pm / g.pm_per_batch) * g.b_batch_stride * 2;
    PG8_WAIT_V(0);
    PG8_STAGE(PG8_SB(0, 0), cB, voffB); PG8_STAGE(PG8_SB(0, 1), cB + hstepB, voffB); PG8_STAGE(PG8_SA(0, 0), cA, voffA); PG8_STAGE(PG8_SA(0, 1), cA + hstepA, voffA);
    if (wr == 1) PG8_BAR;
    PG8_WAIT_V(2); PG8_BAR;
    PG8_STAGE(PG8_SB(1, 0), cB + kstep, voffB); PG8_STAGE(PG8_SA(1, 0), cA + kstep, voffA); PG8_STAGE(PG8_SB(1, 1), cB + hstepB + kstep, voffB);
    PG8_WAIT_V(6); PG8_BAR;
    for (;;) {
        const bool has_next = S.next(ui + 1, nxt);
        const char* nA = has_next ? (const char*)g.A + (size_t)nxt.pm * tstepA : cA;
        const char* nB = has_next ? (const char*)g.Bt + (size_t)nxt.pn * tstepB + (size_t)(nxt.pm / g.pm_per_batch) * g.b_batch_stride * 2 : cB;
        for (int t = 0; t < nt; t += 2) {
            const bool last = (t == nt - 2);
            const char* a1 = cA + (size_t)(t + 1) * kstep;
            const char* a2 = last ? nA : cA + (size_t)(t + 2) * kstep; const char* b2 = last ? nB : cB + (size_t)(t + 2) * kstep;
            const char* a3 = a2 + kstep; const char* b3 = b2 + kstep;
            PG8_LDB(B0, 0, 0); PG8_LDB(B1, 0, 1); PG8_SCHED; PG8_LDA(At, 0, 0); PG8_STAGE(PG8_SA(1, 1), a1 + hstepA, voffA);
            PG8_WAIT_V(8); PG8_WAIT_L(0); PG8_BAR; PG8_MMA(0, 0, At, B0); PG8_MMA(0, 1, At, B1); PG8_BAR; PG8_SCHED;
            PG8_LDA(At, 0, 1); PG8_STAGE(PG8_SB(0, 0), b2, voffB); PG8_STAGE(PG8_SB(0, 1), b2 + hstepB, voffB); PG8_STAGE(PG8_SA(0, 0), a2, voffA);
            PG8_WAIT_V(8); PG8_WAIT_L(0); PG8_BAR; PG8_MMA(1, 0, At, B0); PG8_MMA(1, 1, At, B1); PG8_BAR; PG8_SCHED;
            PG8_LDB(B0, 1, 0); PG8_LDB(B1, 1, 1); PG8_SCHED; PG8_LDA(At, 1, 0); PG8_STAGE(PG8_SA(0, 1), a2 + hstepA, voffA);
            PG8_WAIT_V(8); PG8_WAIT_L(0); PG8_BAR; PG8_MMA(0, 0, At, B0); PG8_MMA(0, 1, At, B1); PG8_BAR; PG8_SCHED;
            PG8_LDA(At, 1, 1); PG8_STAGE(PG8_SB(1, 0), b3, voffB); PG8_STAGE(PG8_SB(1, 1), b3 + hstepB, voffB); PG8_STAGE(PG8_SA(1, 0), a3, voffA);
            PG8_WAIT_V(8); PG8_WAIT_L(0); PG8_BAR; PG8_MMA(1, 0, At, B0); PG8_MMA(1, 1, At, B1); PG8_BAR; PG8_SCHED;
        }
        if (wr == 0) PG8_BAR;
        E(acc, cur, wr, wc, fr, fq);
        if (!has_next) break;
#pragma unroll
        for (int a = 0; a < 2; ++a)
#pragma unroll
            for (int b = 0; b < 2; ++b)
#pragma unroll
                for (int m = 0; m < 4; ++m)
#pragma unroll
                    for (int n = 0; n < 2; ++n) acc[a][b][m][n] = (f32x4){0.f, 0.f, 0.f, 0.f};
        cur = nxt; cA = nA; cB = nB; ++ui;
        if (wr == 1) PG8_BAR;
    }
    PG8_WAIT_V(0);
    PG8_BAR;
#undef PG8_SA
#undef PG8_SB
#undef PG8_STAGE
#undef PG8_LDA
#undef PG8_LDB
#undef PG8_MMA
#undef PG8_WAIT_V
#undef PG8_WAIT_L
#undef PG8_BAR
#undef PG8_SCHED
}
}

__device__ __forceinline__ void st8_bf16(bf16_t* p, const float* v) { *(u32x4*)p = pack8(v); }
__device__ __forceinline__ void st8_f32(float* p, const float* v) { *(f32x4*)p = (f32x4){v[0], v[1], v[2], v[3]}; *(f32x4*)(p + 4) = (f32x4){v[4], v[5], v[6], v[7]}; }

struct FProj {
    bf16_t *HQ, *HI, *HG, *RY, *DQ, *DK, *DV; float *ZF0, *ZF1, *RX; const float *cs, *sn;
    __device__ __forceinline__ void operator()(int row, int col, f32x4 v0, f32x4 v1) const {
        float v[8] = {v0[0], v0[1], v0[2], v0[3], v1[0], v1[1], v1[2], v1[3]};
        const int seg = col >> 8, c = col & 255;
        if (seg == 0) {
#pragma unroll
            for (int i = 0; i < 8; ++i) v[i] = siluf(v[i]);
            st8_bf16(HQ + (size_t)row * 256 + c, v);
        } else if (seg == 1) { st8_f32(ZF0 + (size_t)row * 256 + c, v);
        } else if (seg == 2) { st8_f32(ZF1 + (size_t)row * 256 + c, v);
        } else if (seg == 3) { st8_bf16(HI + (size_t)row * 256 + c, v);
        } else if (seg == 4) {
#pragma unroll
            for (int i = 0; i < 8; ++i) v[i] = siluf(v[i]);
            st8_bf16(HG + (size_t)row * 256 + c, v);
        } else if (seg == 5) { st8_f32(RX + (size_t)row * 256 + c, v);
        } else if (seg == 6) {
#pragma unroll
            for (int i = 0; i < 8; ++i) v[i] = gelu_tanh(v[i]);
            st8_bf16(RY + (size_t)row * 256 + c, v);
        } else if (seg <= 10) {
            const int cc = col - (seg <= 8 ? 1792 : 2304); const int i0 = (cc & 63) >> 1;
            const f32x4 cv = *(const f32x4*)(cs + (size_t)row * 32 + i0), sv = *(const f32x4*)(sn + (size_t)row * 32 + i0);
            float o[8];
#pragma unroll
            for (int k = 0; k < 4; ++k) { const float t1 = v[2 * k], t2 = v[2 * k + 1]; o[2 * k] = t1 * cv[k] - t2 * sv[k]; o[2 * k + 1] = t2 * cv[k] + t1 * sv[k]; }
            if (seg <= 8) {
#pragma unroll
                for (int k = 0; k < 8; ++k) o[k] *= 0.18033688011112042f;
            }
            st8_bf16((seg <= 8 ? DQ : DK) + (size_t)row * 512 + cc, o);
        } else { st8_bf16(DV + (size_t)row * 512 + (col - 2816), v); }
    }
};
struct FRes {
    const float* res; float* out; const float* st; const float* g; const float* b;
    __device__ __forceinline__ void operator()(int row, int col, f32x4 v0, f32x4 v1) const {
        const size_t o = (size_t)row * DM + col; f32x4 r0 = *(const f32x4*)(res + o), r1 = *(const f32x4*)(res + o + 4);
        if (st) { typedef float f32x2 __attribute__((ext_vector_type(2))); const f32x2 ms = *(const f32x2*)(st + (size_t)row * 2);
            r0 = (r0 - ms[0]) * ms[1] * *(const f32x4*)(g + col) + *(const f32x4*)(b + col); r1 = (r1 - ms[0]) * ms[1] * *(const f32x4*)(g + col + 4) + *(const f32x4*)(b + col + 4); }
        *(f32x4*)(out + o) = r0 * ALPHA + v0; *(f32x4*)(out + o + 4) = r1 * ALPHA + v1;
    }
};
struct EpiRes {
    const float* res; float* out; const float* st; const float* g; const float* b;
    __device__ __forceinline__ void operator()(const f32x4 (&acc)[2][2][4][2], const pg8::Unit& u, int wr, int wc, int fr, int fq) const {
        typedef float f32x2 __attribute__((ext_vector_type(2)));
        const int row0 = u.pm * 256 + wr * 64 + fr, colb = u.pn * 256 + wc * 32 + 8 * fq;
#pragma unroll
        for (int ai = 0; ai < 2; ++ai)
#pragma unroll
        for (int mh = 0; mh < 2; ++mh) {
            f32x4 r[2][2][2]; f32x2 ms[2];
#pragma unroll
            for (int mm = 0; mm < 2; ++mm) { const int m = mh * 2 + mm; const size_t o = (size_t)(row0 + ai * 128 + m * 16) * DM + colb;
                r[mm][0][0] = *(const f32x4*)(res + o); r[mm][0][1] = *(const f32x4*)(res + o + 4); r[mm][1][0] = *(const f32x4*)(res + o + 128); r[mm][1][1] = *(const f32x4*)(res + o + 132);
                ms[mm] = st ? *(const f32x2*)(st + (size_t)(row0 + ai * 128 + m * 16) * 2) : (f32x2){0.f, 1.f}; }
#pragma unroll
            for (int bj = 0; bj < 2; ++bj) {
                f32x4 g0 = {1.f, 1.f, 1.f, 1.f}, g1 = g0, b0 = {0.f, 0.f, 0.f, 0.f}, b1 = b0;
                if (st) { g0 = *(const f32x4*)(g + colb + bj * 128); g1 = *(const f32x4*)(g + colb + bj * 128 + 4); b0 = *(const f32x4*)(b + colb + bj * 128); b1 = *(const f32x4*)(b + colb + bj * 128 + 4); }
#pragma unroll
                for (int mm = 0; mm < 2; ++mm) { const int m = mh * 2 + mm; const size_t o = (size_t)(row0 + ai * 128 + m * 16) * DM + colb + bj * 128;
                    f32x4 x0 = r[mm][bj][0], x1 = r[mm][bj][1];
                    if (st) { x0 = (x0 - ms[mm][0]) * ms[mm][1] * g0 + b0; x1 = (x1 - ms[mm][0]) * ms[mm][1] * g1 + b1; }
                    *(f32x4*)(out + o) = x0 * ALPHA + acc[ai][bj][m][0]; *(f32x4*)(out + o + 4) = x1 * ALPHA + acc[ai][bj][m][1]; }
            }
            asm volatile("" ::: "memory");
        }
    }
};
struct FScores {
    bf16_t* P; float* LS;
    __device__ __forceinline__ void operator()(int row, int col, f32x4 v0, f32x4 v1) const {
        float e[8];
#pragma unroll
        for (int i = 0; i < 4; ++i) { e[i] = __expf(v0[i] * 0.0625f - 10.f); e[4 + i] = __expf(v1[i] * 0.0625f - 10.f); }
        const u32x4 w = pack8(e); *(u32x4*)(P + (size_t)row * DM + col) = w;
        float s = (bflo(w.x) + bfhi(w.x)) + (bflo(w.y) + bfhi(w.y)) + (bflo(w.z) + bfhi(w.z)) + (bflo(w.w) + bfhi(w.w));
        s = swap32_sum(swap16_sum(s));
        if ((ltid() & 63) < 16) LS[(size_t)row * 32 + (col >> 8) * 8 + ((col & 255) >> 5)] = s;
    }
};
struct FStore {
    bf16_t* O; int ldc;
    __device__ __forceinline__ void operator()(int row, int col, f32x4 v0, f32x4 v1) const {
        const float v[8] = {v0[0], v0[1], v0[2], v0[3], v1[0], v1[1], v1[2], v1[3]}; st8_bf16(O + (size_t)row * ldc + col, v);
    }
};
struct FUp {
    bf16_t *G, *V;
    __device__ __forceinline__ void operator()(int row, int col, f32x4 v0, f32x4 v1) const {
        const float v[8] = {v0[0], v0[1], v0[2], v0[3], v1[0], v1[1], v1[2], v1[3]};
        if (col < DFF) st8_bf16(G + (size_t)row * DFF + col, v); else st8_bf16(V + (size_t)row * DFF + (col - DFF), v);
    }
};


struct EpiUpConv {
    bf16_t* H; float* SB; const float* cw; const float* cb;
    __device__ __forceinline__ void operator()(const f32x4 (&acc)[2][2][4][2], const pg8::Unit& u, int wr, int wc, int fr, int fq) const {
        const int T0 = u.pm * 256 + wr * 128 + fr * 8, grp = u.pm * 2 + wr;
        f32x4 wq[2][4];
#pragma unroll
        for (int n = 0; n < 2; ++n) { const int c = u.pn * 128 + wc * 32 + fq * 8 + n * 4;
            wq[n][0] = *(const f32x4*)(cw + c); wq[n][1] = *(const f32x4*)(cw + DFF + c); wq[n][2] = *(const f32x4*)(cw + 2 * DFF + c); wq[n][3] = *(const f32x4*)(cb + c); }
#pragma unroll
        for (int n = 0; n < 2; ++n) {
            const int c = u.pn * 128 + wc * 32 + fq * 8 + n * 4;
            const f32x4 w0 = wq[n][0], w1 = wq[n][1], w2 = wq[n][2], bb = wq[n][3];
            f32x4 gp, gn;
#pragma unroll
            for (int e = 0; e < 4; ++e) { gp[e] = dppf<0x111>(acc[1][0][3][n][e]); gn[e] = dppf<0x101>(acc[0][0][0][n][e]); }
#pragma unroll
            for (int k = 0; k < 8; ++k) {
                const f32x4 gc = acc[k >> 2][0][k & 3][n];
                const f32x4 gl = (k == 0) ? gp : acc[(k - 1) >> 2][0][(k - 1) & 3][n];
                const f32x4 gr = (k == 7) ? gn : acc[(k + 1) >> 2][0][(k + 1) & 3][n];
                const f32x4 vv = acc[k >> 2][1][k & 3][n];
                const bool edgeF = (k == 0) && (fr == 0), edgeL = (k == 7) && (fr == 15);
                if (edgeF) { const size_t o = (size_t)grp * DFF + c; *(f32x4*)(SB + 0 * 256 * (size_t)DFF + o) = w1 * gc + w2 * gr + bb; *(f32x4*)(SB + 1 * 256 * (size_t)DFF + o) = vv; *(f32x4*)(SB + 2 * 256 * (size_t)DFF + o) = gc; }
                else if (edgeL) { const size_t o = (size_t)grp * DFF + c; *(f32x4*)(SB + 3 * 256 * (size_t)DFF + o) = w0 * gl + w1 * gc + bb; *(f32x4*)(SB + 4 * 256 * (size_t)DFF + o) = vv; *(f32x4*)(SB + 5 * 256 * (size_t)DFF + o) = gc; }
                else { const f32x4 a = w0 * gl + w1 * gc + w2 * gr + bb;
                    u32x2 w; w.x = cvt_pk_bf16(gelu_tanh(a[0]) * vv[0], gelu_tanh(a[1]) * vv[1]); w.y = cvt_pk_bf16(gelu_tanh(a[2]) * vv[2], gelu_tanh(a[3]) * vv[3]);
                    *(u32x2*)(H + (size_t)(T0 + k) * DFF + c) = w; }
            }
            asm volatile("" ::: "memory");
        }
    }
};

namespace att {
constexpr int NW = 8, QBLK = 32, KVBLK = 64, LDQ = 512;
constexpr float SCALE = 0.125f, THR = 8.f;
constexpr int SHM_V = KVBLK * 128 * 2, SHM_K = KVBLK * 64 * 2;
#define KSWZ(row, colB) ((row) * 128 + ((colB) ^ ((((row) >> 1) & 7) << 4)))
#define SBAR() __builtin_amdgcn_sched_barrier(0)
__device__ __forceinline__ int crow(int r, int hi) { return (r & 3) + 8 * (r >> 2) + 4 * hi; }
__device__ __forceinline__ void partialSM(f32x16& p0, f32x16& p1, float& m_ref, float& alpha, bool first) {
  constexpr float THRL = THR * 1.4426950408889634f;
  float pmax = p0[0];
#pragma unroll
  for (int r = 1; r < 16; ++r) pmax = fmaxf(pmax, p0[r]);
#pragma unroll
  for (int r = 0; r < 16; ++r) pmax = fmaxf(pmax, p1[r]);
  { auto rr = __builtin_amdgcn_permlane32_swap(__float_as_uint(pmax), __float_as_uint(pmax), false, false);
    pmax = fmaxf(__uint_as_float(rr[0]), __uint_as_float(rr[1])); }
  if (__builtin_expect(!first && __all(pmax <= THRL), 1)) { alpha = 1.f; }
  else { const float dl = first ? pmax : fmaxf(pmax, 0.f); m_ref += dl; alpha = first ? 1.f : __builtin_amdgcn_exp2f(-dl);
#pragma unroll
    for (int r = 0; r < 16; ++r) { p0[r] -= dl; p1[r] -= dl; } }
#pragma unroll
  for (int r = 0; r < 16; ++r) p0[r] = __builtin_amdgcn_exp2f(p0[r]);
}
__device__ __forceinline__ void finishSM(f32x16& p0, f32x16& p1, float alpha, float& l_reg, bf16x8& pa0, bf16x8& pa1, bf16x8& pa2, bf16x8& pa3) {
#pragma unroll
  for (int r = 0; r < 16; ++r) p1[r] = __builtin_amdgcn_exp2f(p1[r]);
  float ps = 0;
#pragma unroll
  for (int r = 0; r < 16; ++r) ps += p0[r];
#pragma unroll
  for (int r = 0; r < 16; ++r) ps += p1[r];
  { auto rr = __builtin_amdgcn_permlane32_swap(__float_as_uint(ps), __float_as_uint(ps), false, false);
    ps = __uint_as_float(rr[0]) + __uint_as_float(rr[1]); }
  l_reg = l_reg * alpha + ps;
#define PK4(P, BASE, OUT) do { unsigned a0 = cvt_pk_bf16(P[BASE + 0], P[BASE + 1]), a1 = cvt_pk_bf16(P[BASE + 2], P[BASE + 3]);   \
    unsigned b0 = cvt_pk_bf16(P[BASE + 4], P[BASE + 5]), b1 = cvt_pk_bf16(P[BASE + 6], P[BASE + 7]);                              \
    auto r0 = __builtin_amdgcn_permlane32_swap(a0, b0, false, false); auto r1 = __builtin_amdgcn_permlane32_swap(a1, b1, false, false); \
    u32x4 w = {r0[0], r1[0], r0[1], r1[1]}; OUT = *reinterpret_cast<bf16x8*>(&w); } while (0)
  PK4(p0, 0, pa0); PK4(p0, 8, pa1); PK4(p1, 0, pa2); PK4(p1, 8, pa3);
#undef PK4
}
__device__ __forceinline__ void qkt(f32x16& p0, f32x16& p1, const char* Ks, const bf16x8* qr, int r32, int hi, float m_ref) {
#pragma unroll
  for (int r = 0; r < 16; ++r) { p0[r] = -m_ref; p1[r] = -m_ref; }
#pragma unroll
  for (int d0 = 0; d0 < 4; ++d0) { const int cb = (d0 * 16 + hi * 8) * 2;
    bf16x8 b0 = *reinterpret_cast<const bf16x8*>(Ks + KSWZ(r32, cb));
    bf16x8 b1 = *reinterpret_cast<const bf16x8*>(Ks + KSWZ(32 + r32, cb));
    p0 = __builtin_amdgcn_mfma_f32_32x32x16_bf16(b0, qr[d0], p0, 0, 0, 0);
    p1 = __builtin_amdgcn_mfma_f32_32x32x16_bf16(b1, qr[d0], p1, 0, 0, 0); }
}
__device__ __forceinline__ int v_st(int k, int c) { const int kk = (k & ~0xC) | ((k & 4) << 1) | ((k & 8) >> 1); return ((kk >> 3) * 4 + (c >> 5)) * 512 + ((kk & 7) * 32 + (c & 31)) * 2; }
__device__ __forceinline__ int v_rd_base(int lane) { return ((lane & 3) << 3) | (((lane >> 2) & 3) << 6) | (((lane >> 4) & 1) << 5) | (((lane >> 5) & 1) << 8); }
constexpr int v_rd_off(int d0, int ks, int half) { return d0 * 512 + ks * 4096 + half * 2048; }
template <int OFF> __device__ __forceinline__ s16x4 tr_read(int vb) {
  s16x4 r; asm volatile("ds_read_b64_tr_b16 %0, %1 offset:%2" : "=&v"(r) : "v"(vb), "i"(OFF) : "memory"); return r;
}
template <int D0> __device__ __forceinline__ void pv_one(f32x16& od, int vb, bf16x8 pa0, bf16x8 pa1, bf16x8 pa2, bf16x8 pa3) {
  const s16x4 l0 = tr_read<v_rd_off(D0, 0, 0)>(vb), h0 = tr_read<v_rd_off(D0, 0, 1)>(vb), l1 = tr_read<v_rd_off(D0, 1, 0)>(vb), h1 = tr_read<v_rd_off(D0, 1, 1)>(vb);
  const s16x4 l2 = tr_read<v_rd_off(D0, 2, 0)>(vb), h2 = tr_read<v_rd_off(D0, 2, 1)>(vb), l3 = tr_read<v_rd_off(D0, 3, 0)>(vb), h3 = tr_read<v_rd_off(D0, 3, 1)>(vb);
  asm volatile("s_waitcnt lgkmcnt(0)" ::: "memory"); SBAR();
#define PK(L, H) (bf16x8){L[0], L[1], L[2], L[3], H[0], H[1], H[2], H[3]}
  od = __builtin_amdgcn_mfma_f32_32x32x16_bf16(pa0, PK(l0, h0), od, 0, 0, 0);
  od = __builtin_amdgcn_mfma_f32_32x32x16_bf16(pa1, PK(l1, h1), od, 0, 0, 0);
  od = __builtin_amdgcn_mfma_f32_32x32x16_bf16(pa2, PK(l2, h2), od, 0, 0, 0);
  od = __builtin_amdgcn_mfma_f32_32x32x16_bf16(pa3, PK(l3, h3), od, 0, 0, 0);
#undef PK
}
__device__ __forceinline__ void pv_d0(f32x16* o, int vb, bf16x8 pa0, bf16x8 pa1, bf16x8 pa2, bf16x8 pa3) {
  pv_one<0>(o[0], vb, pa0, pa1, pa2, pa3); pv_one<1>(o[1], vb, pa0, pa1, pa2, pa3); pv_one<2>(o[2], vb, pa0, pa1, pa2, pa3); pv_one<3>(o[3], vb, pa0, pa1, pa2, pa3);
}
__device__ __forceinline__ void attn_unit(const bf16_t* __restrict__ Qb, const bf16_t* __restrict__ Kh, const bf16_t* __restrict__ Vh, int seq, char* lds,
                                          int mode, float* scratch, float lam, float gscale, const float* __restrict__ subg, bf16_t* outp) {
  int tid_ = threadIdx.x; asm volatile("" : "+v"(tid_));
  const int tid = tid_, wid = tid >> 6, lane = tid & 63, r32 = lane & 31, hi = lane >> 5;
  char* V_lds = lds; char* K_lds = lds + 3 * SHM_V;
  float* ws = (float*)(lds + 3 * SHM_V + 3 * SHM_K) + wid * 64; float* li_l = ws; float* al_l = ws + 32;
  float m_reg = 0.f, l_reg = 0; f32x16 o[4] = {}; bf16x8 qr[4];
  const bf16_t* Qw = Qb + (long)(wid * QBLK + r32) * LDQ + hi * 8;
#pragma unroll
  for (int d0 = 0; d0 < 4; ++d0) qr[d0] = *reinterpret_cast<const bf16x8*>(Qw + d0 * 16);
  const int sr = tid >> 4, sc = (tid & 15) * 8, vst0 = v_st(sr, sc), vst1 = v_st(32 + sr, sc);
  const int kr = tid >> 3, kc = (tid & 7) * 8, kst = KSWZ(kr, kc * 2);
  const int vb0 = (int)(uintptr_t)V_lds + v_rd_base(lane);
  struct { bf16x8 vs0, vs1, ks0; } sr_[2];
#define SLOAD(i, k0) do { sr_[i].vs0 = *reinterpret_cast<const bf16x8*>(&Vh[(long)((k0) + sr) * LDQ + sc]); sr_[i].vs1 = *reinterpret_cast<const bf16x8*>(&Vh[(long)((k0) + 32 + sr) * LDQ + sc]); \
    sr_[i].ks0 = *reinterpret_cast<const bf16x8*>(&Kh[(long)((k0) + kr) * LDQ + kc]); } while (0)
#define SWRITE(b, i) do { *(bf16x8*)(V_lds + (b) * SHM_V + vst0) = sr_[i].vs0; *(bf16x8*)(V_lds + (b) * SHM_V + vst1) = sr_[i].vs1; \
    *(bf16x8*)(K_lds + (b) * SHM_K + kst) = sr_[i].ks0; } while (0)
#define SWAIT() asm volatile("s_waitcnt vmcnt(3)" ::: "memory")
#define RESC(a) do { if (__any((a) < 1.f)) { if (hi == 0) al_l[r32] = (a); asm volatile("s_waitcnt lgkmcnt(0)" ::: "memory"); \
    _Pragma("unroll") for (int d = 0; d < 4; ++d) _Pragma("unroll") for (int r = 0; r < 16; ++r) o[d][r] *= al_l[crow(r, hi)]; } } while (0)
  f32x16 pA0, pA1, pB0, pB1; float alA, alB; bf16x8 pa0, pa1, pa2, pa3; const int NT = seq / KVBLK;
  constexpr int SE = 0, SO = 1;
  SLOAD(SE, 0); asm volatile("s_waitcnt vmcnt(0)" ::: "memory"); SWRITE(0, SE); __syncthreads();
  qkt(pA0, pA1, K_lds, qr, r32, hi, m_reg); partialSM(pA0, pA1, m_reg, alA, true);
  SLOAD(SO, KVBLK); if (2 < NT) SLOAD(SE, 2 * KVBLK);
  SWAIT(); SWRITE(1, SO); __syncthreads();
  int bp = 0, bc = 1, bn = 2;
#define ROT3() do { const int t_ = bp; bp = bc; bc = bn; bn = t_; } while (0)
  if (wid >= 4) __builtin_amdgcn_s_setprio(1);
  for (int j = 1; j + 1 < NT; j += 2) {
    SBAR(); qkt(pB0, pB1, K_lds + bc * SHM_K, qr, r32, hi, m_reg);
    finishSM(pA0, pA1, alA, l_reg, pa0, pa1, pa2, pa3); SBAR();
    SLOAD(SO, (j + 2) * KVBLK); SBAR();
    pv_d0(o, vb0 + bp * SHM_V, pa0, pa1, pa2, pa3); partialSM(pB0, pB1, m_reg, alB, false);
    SWAIT(); SWRITE(bn, SE);
    RESC(alB); __syncthreads(); ROT3();
    SBAR(); qkt(pA0, pA1, K_lds + bc * SHM_K, qr, r32, hi, m_reg);
    finishSM(pB0, pB1, alB, l_reg, pa0, pa1, pa2, pa3); SBAR();
    if (j + 3 < NT) SLOAD(SE, (j + 3) * KVBLK); SBAR();
    pv_d0(o, vb0 + bp * SHM_V, pa0, pa1, pa2, pa3); partialSM(pA0, pA1, m_reg, alA, false);
    SWAIT(); SWRITE(bn, SO);
    RESC(alA); __syncthreads(); ROT3();
  }
  SBAR(); qkt(pB0, pB1, K_lds + bc * SHM_K, qr, r32, hi, m_reg);
  finishSM(pA0, pA1, alA, l_reg, pa0, pa1, pa2, pa3); SBAR();
  pv_d0(o, vb0 + bp * SHM_V, pa0, pa1, pa2, pa3); partialSM(pB0, pB1, m_reg, alB, false);
  RESC(alB);
  finishSM(pB0, pB1, alB, l_reg, pa0, pa1, pa2, pa3); SBAR();
  pv_d0(o, vb0 + bc * SHM_V, pa0, pa1, pa2, pa3);
  __builtin_amdgcn_s_setprio(0);
#undef ROT3
  if (hi == 0) li_l[r32] = l_reg; asm volatile("s_waitcnt lgkmcnt(0)" ::: "memory");
  float* sw = scratch + (long)(wid * QBLK) * 128;
  if (mode == 0) {
#pragma unroll
    for (int r = 0; r < 16; ++r) { const int orow = crow(r, hi); const float rl = __builtin_amdgcn_rcpf(li_l[orow]);
#pragma unroll
      for (int d0 = 0; d0 < 4; ++d0) sw[orow * 128 + d0 * 32 + r32] = o[d0][r] * rl; }
  } else {
    bf16_t* ow = outp + (long)(wid * QBLK) * 1024;
    float g4[4];
#pragma unroll
    for (int d0 = 0; d0 < 4; ++d0) g4[d0] = subg[d0 * 32 + r32] * gscale;
#pragma unroll
    for (int r = 0; r < 16; ++r) { const int orow = crow(r, hi); const float rl = __builtin_amdgcn_rcpf(li_l[orow]) * lam;
      float x[4]; float ss = 0.f;
#pragma unroll
      for (int d0 = 0; d0 < 4; ++d0) { x[d0] = sw[orow * 128 + d0 * 32 + r32] - o[d0][r] * rl; ss += x[d0] * x[d0]; }
      ss = sum32(ss);
      const float rn = rsqrtf(ss * (1.f / 128.f) + 1e-6f);
#pragma unroll
      for (int d0 = 0; d0 < 4; ++d0) ow[orow * 1024 + d0 * 32 + r32] = (bf16_t)f2bf(x[d0] * rn * g4[d0]); }
  }
  __syncthreads();
#undef SLOAD
#undef SWRITE
#undef SWAIT
#undef RESC
}
#undef KSWZ
#undef SBAR
}

namespace hg {
constexpr int ST = 65;
constexpr int O_Q = 0, O_K = 4160, O_B = 8320, O_QB = 12480, O_KS = 16640, O_V = 22880, O_S = 26976, O_TMP = 31072;
__device__ __forceinline__ int ksbase(int I) { return I == 0 ? O_KS : I == 1 ? O_KS + 16 * ST : I == 2 ? O_KS + 48 * ST : O_K; }
__device__ __forceinline__ f32x4 mm4(float a, float b, f32x4 c) { return __builtin_amdgcn_mfma_f32_16x16x4f32(a, b, c, 0, 0, 0); }
__device__ __forceinline__ void load_gates(LAS float* sm, const float* ZF, const float* lbt, int tok0, int h, int dir, int tid) {
    const int tl = tid >> 3, c8 = (tid & 7) * 8, j = dir ? 63 - tl : tl;
    const float* zp = ZF + (size_t)(tok0 + tl) * 256 + h * 64 + c8;
    const f32x4 z0 = *(const f32x4*)zp, z1 = *(const f32x4*)(zp + 4);
    const f32x4 l0 = *(const f32x4*)(lbt + h * 64 + c8), l1 = *(const f32x4*)(lbt + h * 64 + c8 + 4);
    const float z[8] = {z0[0], z0[1], z0[2], z0[3], z1[0], z1[1], z1[2], z1[3]}, lb[8] = {l0[0], l0[1], l0[2], l0[3], l1[0], l1[1], l1[2], l1[3]};
#pragma unroll
    for (int e = 0; e < 8; ++e) { const float sg = __builtin_amdgcn_rcpf(1.f + __expf(-z[e])); const float f = lb[e] + (1.f - lb[e]) * sg;
        sm[O_B + j * ST + c8 + e] = __logf(f); sm[O_K + j * ST + c8 + e] = (1.f - lb[e]) * __builtin_amdgcn_rcpf(1.f + __expf(z[e])); }
}
__device__ __forceinline__ void cumsum_b(LAS float* sm, int tid) {
    const int d = tid & 63, seg = tid >> 6; float run = 0.f;
#pragma unroll
    for (int r = 0; r < 8; ++r) { const int ix = O_B + (seg * 8 + r) * ST + d; run += sm[ix]; sm[ix] = run; }
    sm[O_TMP + seg * 64 + d] = run;
    __syncthreads();
    float off = 0.f;
    for (int s = 0; s < seg; ++s) off += sm[O_TMP + s * 64 + d];
#pragma unroll
    for (int r = 0; r < 8; ++r) sm[O_B + (seg * 8 + r) * ST + d] += off;
    __syncthreads();
}
__device__ __forceinline__ void load_bf16_tile(LAS float* dst, int stride, const bf16_t* src, int tok0, int h, int dir, int tid) {
    const int tl = tid >> 3, c8 = (tid & 7) * 8, j = dir ? 63 - tl : tl;
    const u32x4 w = *(const u32x4*)(src + (size_t)(tok0 + tl) * 256 + h * 64 + c8); float v[8]; unpack8(w, v);
#pragma unroll
    for (int e = 0; e < 8; ++e) dst[j * stride + c8 + e] = v[e];
}
__device__ __forceinline__ void unit_a(LAS float* sm, int u, const float* ZF0, const float* ZF1, const bf16_t* HI, const float* lbt, float* STB, float* HD) {
    const int tid = ltid(), lane = tid & 63, w = tid >> 6; const int chunk = u & 255, dir = (u >> 8) & 1, h = (u >> 9) & 3, b = u >> 11;
    const int tok0 = b * SEQ + chunk * 64;
    load_gates(sm, dir ? ZF1 : ZF0, lbt + dir * 256, tok0, h, dir, tid);
    load_bf16_tile(sm + O_V, 64, HI, tok0, h, dir, tid);
    __syncthreads();
    cumsum_b(sm, tid);
    { const int d = tid & 63, seg = tid >> 6; const float bl = sm[O_B + 63 * ST + d];
#pragma unroll
      for (int r = 0; r < 8; ++r) { const int ix = (seg * 8 + r) * ST + d; sm[O_K + ix] *= __expf(bl - sm[O_B + ix]); } }
    __syncthreads();
    const int stream = (b * 4 + h) * 2 + dir, p = dir ? 255 - chunk : chunk;
    const int fr = lane & 15, fq = lane >> 4;
#pragma unroll
    for (int tt = 0; tt < 2; ++tt) { const int T = 2 * w + tt, di = T >> 2, ei = T & 3; f32x4 acc = {0.f, 0.f, 0.f, 0.f};
#pragma unroll 4
        for (int k0 = 0; k0 < 64; k0 += 4) acc = mm4(sm[O_K + (k0 + fq) * ST + 16 * di + fr], sm[O_V + (k0 + fq) * 64 + 16 * ei + fr], acc);
        asm volatile("s_nop 15\n\ts_nop 7" : "+v"(acc));
        float* up = STB + ((size_t)(stream * 256 + p)) * 4096 + (16 * di + 4 * fq) * 64 + 16 * ei + fr;
#pragma unroll
        for (int r = 0; r < 4; ++r) up[r * 64] = acc[r]; }
    if (tid < 64) HD[(size_t)(stream * 256 + p) * 64 + tid] = __expf(sm[O_B + 63 * ST + tid]);
    __syncthreads();
}
struct PreA { f32x4 z0, z1; u32x4 v; };
__device__ __forceinline__ PreA issue_a(int u, const float* ZF0, const float* ZF1, const bf16_t* HI, int tid) {
    const int chunk = u & 255, dir = (u >> 8) & 1, h = (u >> 9) & 3, b = u >> 11; const int tok0 = b * SEQ + chunk * 64; const int tl = tid >> 3, c8 = (tid & 7) * 8;
    const float* zp = (dir ? ZF1 : ZF0) + (size_t)(tok0 + tl) * 256 + h * 64 + c8;
    PreA p; p.z0 = *(const f32x4*)zp; p.z1 = *(const f32x4*)(zp + 4); p.v = *(const u32x4*)(HI + (size_t)(tok0 + tl) * 256 + h * 64 + c8); return p;
}
__device__ __forceinline__ void unit_a_pre(LAS float* sm, int u, const PreA& pre, const float* lbt0, float* STB, float* HD, int tid) {
    const int lane = tid & 63, w = __builtin_amdgcn_readfirstlane(tid >> 6); const int chunk = u & 255, dir = (u >> 8) & 1, h = (u >> 9) & 3, b = u >> 11;
    { const int tl = tid >> 3, c8 = (tid & 7) * 8, j = dir ? 63 - tl : tl; const float* lbt = lbt0 + dir * 256;
      const f32x4 l0 = *(const f32x4*)(lbt + h * 64 + c8), l1 = *(const f32x4*)(lbt + h * 64 + c8 + 4);
      const float z[8] = {pre.z0[0], pre.z0[1], pre.z0[2], pre.z0[3], pre.z1[0], pre.z1[1], pre.z1[2], pre.z1[3]}, lb[8] = {l0[0], l0[1], l0[2], l0[3], l1[0], l1[1], l1[2], l1[3]};
      float v[8]; unpack8(pre.v, v);
#pragma unroll
      for (int e = 0; e < 8; ++e) { const float sg = __builtin_amdgcn_rcpf(1.f + __expf(-z[e])); const float f = lb[e] + (1.f - lb[e]) * sg;
          sm[O_B + j * ST + c8 + e] = __logf(f); sm[O_K + j * ST + c8 + e] = (1.f - lb[e]) * __builtin_amdgcn_rcpf(1.f + __expf(z[e])); sm[O_V + j * 64 + c8 + e] = v[e]; } }
    __syncthreads();
    cumsum_b(sm, tid);
    { const int d = tid & 63, seg = tid >> 6; const float bl = sm[O_B + 63 * ST + d];
#pragma unroll
      for (int r = 0; r < 8; ++r) { const int ix = (seg * 8 + r) * ST + d; sm[O_K + ix] *= __expf(bl - sm[O_B + ix]); } }
    __syncthreads();
    const int stream = (b * 4 + h) * 2 + dir, p = dir ? 255 - chunk : chunk;
    const int fr = lane & 15, fq = lane >> 4;
#pragma unroll
    for (int tt = 0; tt < 2; ++tt) { const int T = 2 * w + tt, di = T >> 2, ei = T & 3; f32x4 acc = {0.f, 0.f, 0.f, 0.f};
#pragma unroll 4
        for (int k0 = 0; k0 < 64; k0 += 4) acc = mm4(sm[O_K + (k0 + fq) * ST + 16 * di + fr], sm[O_V + (k0 + fq) * 64 + 16 * ei + fr], acc);
        asm volatile("s_nop 15\n\ts_nop 7" : "+v"(acc));
        float* up = STB + ((size_t)(stream * 256 + p)) * 4096 + (16 * di + 4 * fq) * 64 + 16 * ei + fr;
#pragma unroll
        for (int r = 0; r < 4; ++r) up[r * 64] = acc[r]; }
    if (tid < 64) HD[(size_t)(stream * 256 + p) * 64 + tid] = __expf(sm[O_B + 63 * ST + tid]);
    __syncthreads();
}
__device__ __forceinline__ void phase_a(LAS float* sm, int bx, int G, const float* ZF0, const float* ZF1, const bf16_t* HI, const float* lbt0, float* STB, float* HD) {
    const int tid = ltid(); int u = bx; if (u >= 4096) return;
    PreA pre = issue_a(u, ZF0, ZF1, HI, tid);
#pragma unroll 1
    for (; u < 4096; u += G) { PreA nxt = pre; if (u + G < 4096) nxt = issue_a(u + G, ZF0, ZF1, HI, tid);
        unit_a_pre(sm, u, pre, lbt0, STB, HD, tid); pre = nxt; }
}
__device__ __forceinline__ void phase_b(float* STB, const float* HD) {
    const int gid = lbid() * 512 + ltid(); if (gid >= 65536) return;
    const int stream = gid >> 12, de = gid & 4095, d = de >> 6;
    float* sp = STB + (size_t)stream * 256 * 4096 + de; const float* dp = HD + (size_t)stream * 256 * 64 + d;
    float S = 0.f;
    for (int p = 0; p < 256; p += 32) {
        float uu[32], dc[32];
#pragma unroll
        for (int i = 0; i < 32; ++i) { uu[i] = sp[(size_t)(p + i) * 4096]; dc[i] = dp[(p + i) * 64]; }
#pragma unroll
        for (int i = 0; i < 32; ++i) { sp[(size_t)(p + i) * 4096] = S; S = dc[i] * S + uu[i]; }
    }
}
__device__ __forceinline__ void unit_c(LAS float* sm, int u, const float* ZF0, const float* ZF1, const bf16_t* HQ, const bf16_t* HI, const bf16_t* HGs, const float* lbt, const float* STB,
                                       const float* normg, bf16_t* MIX) {
    const int tid = ltid(), lane = tid & 63, w = tid >> 6; const int chunk = u & 255, h = (u >> 8) & 3, b = u >> 10;
    const int tok0 = b * SEQ + chunk * 64; const int fr = lane & 15, fq = lane >> 4;
    f32x4 oacc[2] = {{0.f, 0.f, 0.f, 0.f}, {0.f, 0.f, 0.f, 0.f}};
#pragma unroll 1
    for (int dir = 0; dir < 2; ++dir) {
        load_gates(sm, dir ? ZF1 : ZF0, lbt + dir * 256, tok0, h, dir, tid);
        load_bf16_tile(sm + O_Q, ST, HQ, tok0, h, dir, tid);
        load_bf16_tile(sm + O_V, 64, HI, tok0, h, dir, tid);
        { const int stream = (b * 4 + h) * 2 + dir, p = dir ? 255 - chunk : chunk; const float* sp = STB + ((size_t)(stream * 256 + p)) * 4096 + tid * 8;
          *(LAS f32x4*)(sm + O_S + tid * 8) = *(const f32x4*)sp; *(LAS f32x4*)(sm + O_S + tid * 8 + 4) = *(const f32x4*)(sp + 4); }
        __syncthreads();
        cumsum_b(sm, tid);
        { const int d = tid & 63, seg = tid >> 6, I = seg >> 1;
          float rj[4]; rj[0] = 0.f; rj[1] = sm[O_B + 15 * ST + d]; rj[2] = sm[O_B + 31 * ST + d]; rj[3] = sm[O_B + 47 * ST + d];
#pragma unroll
          for (int r = 0; r < 8; ++r) { const int ix = (seg * 8 + r) * ST + d; const float bt = sm[O_B + ix], q = sm[O_Q + ix], k = sm[O_K + ix];
              sm[O_QB + ix] = q * __expf(bt);
              sm[O_Q + ix] = q * __expf(bt - (I == 0 ? rj[0] : I == 1 ? rj[1] : I == 2 ? rj[2] : rj[3]));
#pragma unroll
              for (int J = 0; J < 4; ++J) if (J >= I) sm[ksbase(J) + ix] = k * __expf(fminf(rj[J] - bt, 80.f)); } }
        __syncthreads();
#pragma unroll 1
        for (int T = w; T < 10; T += 8) {
            const int I = T < 1 ? 0 : T < 3 ? 1 : T < 6 ? 2 : 3, J = T - (I * (I + 1)) / 2; const int kb = ksbase(I); f32x4 acc = {0.f, 0.f, 0.f, 0.f};
#pragma unroll 4
            for (int k0 = 0; k0 < 64; k0 += 4) acc = mm4(sm[O_Q + (16 * I + fr) * ST + k0 + fq], sm[kb + (16 * J + fr) * ST + k0 + fq], acc);
            asm volatile("s_nop 15\n\ts_nop 7" : "+v"(acc));
#pragma unroll
            for (int r = 0; r < 4; ++r) { const int t = 16 * I + 4 * fq + r, sx = 16 * J + fr; sm[O_B + t * ST + sx] = (sx <= t) ? acc[r] : 0.f; } }
        __syncthreads();
#pragma unroll
        for (int tt = 0; tt < 2; ++tt) { const int T = 2 * w + tt, ti = T >> 2, ei = T & 3; const int j = dir ? 63 - (16 * ti + fr) : 16 * ti + fr; const int ks = dir ? 4 * (4 - ti) : 4 * (ti + 1);
            f32x4 acc = {0.f, 0.f, 0.f, 0.f};
#pragma unroll 4
            for (int k0 = 0; k0 < 64; k0 += 4) acc = mm4(sm[O_QB + j * ST + k0 + fq], sm[O_S + (k0 + fq) * 64 + 16 * ei + fr], acc);
            for (int kk = 0; kk < ks; ++kk) acc = mm4(sm[O_B + j * ST + 4 * kk + fq], sm[O_V + (4 * kk + fq) * 64 + 16 * ei + fr], acc);
            asm volatile("s_nop 15\n\ts_nop 7" : "+v"(acc)); oacc[tt] += acc; }
        __syncthreads();
    }
#pragma unroll
    for (int tt = 0; tt < 2; ++tt) { const int T = 2 * w + tt, ti = T >> 2, ei = T & 3;
#pragma unroll
        for (int r = 0; r < 4; ++r) sm[O_Q + (16 * ti + 4 * fq + r) * ST + 16 * ei + fr] = oacc[tt][r]; }
    __syncthreads();
    const int tl = tid >> 3, e0 = (tid & 7) * 8;
    float ov[8]; float ss = 0.f;
#pragma unroll
    for (int e = 0; e < 8; ++e) { ov[e] = sm[O_Q + tl * ST + e0 + e]; ss += ov[e] * ov[e]; }
    ss = sum8(ss);
    const float rn = rsqrtf(ss * (1.f / 64.f) + 1e-6f);
    const size_t tok = (size_t)(tok0 + tl);
    float gv[8]; unpack8(*(const u32x4*)(HGs + tok * 256 + h * 64 + e0), gv);
    const f32x4 n0 = *(const f32x4*)(normg + h * 64 + e0), n1 = *(const f32x4*)(normg + h * 64 + e0 + 4);
    const float ng[8] = {n0[0], n0[1], n0[2], n0[3], n1[0], n1[1], n1[2], n1[3]};
#pragma unroll
    for (int e = 0; e < 8; ++e) ov[e] = ov[e] * rn * ng[e] * gv[e];
    st8_bf16(MIX + tok * 1024 + h * 64 + e0, ov);
    __syncthreads();
}
struct PreC { f32x4 z0, z1, s0, s1; u32x4 q, v; };
__device__ __forceinline__ PreC issue_c(int u, int dir, const float* ZF0, const float* ZF1, const bf16_t* HQ, const bf16_t* HI, const float* STB, int tid) {
    const int chunk = u & 255, h = (u >> 8) & 3, b = u >> 10; const int tok0 = b * SEQ + chunk * 64; const int tl = tid >> 3, c8 = (tid & 7) * 8;
    const float* zp = (dir ? ZF1 : ZF0) + (size_t)(tok0 + tl) * 256 + h * 64 + c8;
    const int stream = (b * 4 + h) * 2 + dir, p = dir ? 255 - chunk : chunk; const float* sp = STB + ((size_t)(stream * 256 + p)) * 4096 + tid * 8;
    PreC r; r.z0 = *(const f32x4*)zp; r.z1 = *(const f32x4*)(zp + 4); r.q = *(const u32x4*)(HQ + (size_t)(tok0 + tl) * 256 + h * 64 + c8); r.v = *(const u32x4*)(HI + (size_t)(tok0 + tl) * 256 + h * 64 + c8);
    r.s0 = *(const f32x4*)sp; r.s1 = *(const f32x4*)(sp + 4); return r;
}
__device__ __forceinline__ void phase_c(LAS float* sm, int bx, int G, const float* ZF0, const float* ZF1, const bf16_t* HQ, const bf16_t* HI, const bf16_t* HGs, const float* lbt, const float* STB,
                                        const float* normg, bf16_t* MIX) {
    const int tid = ltid(), lane = tid & 63, w = __builtin_amdgcn_readfirstlane(tid >> 6); const int fr = lane & 15, fq = lane >> 4;
    int u = bx; if (u >= 2048) return;
    PreC pre = issue_c(u, 0, ZF0, ZF1, HQ, HI, STB, tid);
#pragma unroll 1
    for (; u < 2048; u += G) {
    const int chunk = u & 255, h = (u >> 8) & 3, b = u >> 10; const int tok0 = b * SEQ + chunk * 64;
    f32x4 oacc[2] = {{0.f, 0.f, 0.f, 0.f}, {0.f, 0.f, 0.f, 0.f}};
#pragma unroll 1
    for (int dir = 0; dir < 2; ++dir) {
        {
            const int tl = tid >> 3, c8 = (tid & 7) * 8, j = dir ? 63 - tl : tl; const float* lbd = lbt + dir * 256;
            const f32x4 l0 = *(const f32x4*)(lbd + h * 64 + c8), l1 = *(const f32x4*)(lbd + h * 64 + c8 + 4);
            const float z[8] = {pre.z0[0], pre.z0[1], pre.z0[2], pre.z0[3], pre.z1[0], pre.z1[1], pre.z1[2], pre.z1[3]}, lb[8] = {l0[0], l0[1], l0[2], l0[3], l1[0], l1[1], l1[2], l1[3]};
            float qv[8], vv[8]; unpack8(pre.q, qv); unpack8(pre.v, vv);
#pragma unroll
            for (int e = 0; e < 8; ++e) { const float sg = __builtin_amdgcn_rcpf(1.f + __expf(-z[e])); const float f = lb[e] + (1.f - lb[e]) * sg;
                sm[O_B + j * ST + c8 + e] = __logf(f); sm[O_K + j * ST + c8 + e] = (1.f - lb[e]) * __builtin_amdgcn_rcpf(1.f + __expf(z[e]));
                sm[O_Q + j * ST + c8 + e] = qv[e]; sm[O_V + j * 64 + c8 + e] = vv[e]; }
            *(LAS f32x4*)(sm + O_S + tid * 8) = pre.s0; *(LAS f32x4*)(sm + O_S + tid * 8 + 4) = pre.s1;
            if (dir == 0) pre = issue_c(u, 1, ZF0, ZF1, HQ, HI, STB, tid); else if (u + G < 2048) pre = issue_c(u + G, 0, ZF0, ZF1, HQ, HI, STB, tid);
        }
        __syncthreads();
        cumsum_b(sm, tid);
        { const int d = tid & 63, seg = tid >> 6, I = seg >> 1;
          float rj[4]; rj[0] = 0.f; rj[1] = sm[O_B + 15 * ST + d]; rj[2] = sm[O_B + 31 * ST + d]; rj[3] = sm[O_B + 47 * ST + d];
#pragma unroll
          for (int r = 0; r < 8; ++r) { const int ix = (seg * 8 + r) * ST + d; const float bt = sm[O_B + ix], q = sm[O_Q + ix], k = sm[O_K + ix];
              sm[O_QB + ix] = q * __expf(bt);
              sm[O_Q + ix] = q * __expf(bt - (I == 0 ? rj[0] : I == 1 ? rj[1] : I == 2 ? rj[2] : rj[3]));
#pragma unroll
              for (int J = 0; J < 4; ++J) if (J >= I) sm[ksbase(J) + ix] = k * __expf(fminf(rj[J] - bt, 80.f)); } }
        __syncthreads();
#pragma unroll 1
        for (int T = w; T < 10; T += 8) {
            const int I = T < 1 ? 0 : T < 3 ? 1 : T < 6 ? 2 : 3, J = T - (I * (I + 1)) / 2; const int kb = ksbase(I); f32x4 acc = {0.f, 0.f, 0.f, 0.f};
#pragma unroll 4
            for (int k0 = 0; k0 < 64; k0 += 4) acc = mm4(sm[O_Q + (16 * I + fr) * ST + k0 + fq], sm[kb + (16 * J + fr) * ST + k0 + fq], acc);
            asm volatile("s_nop 15\n\ts_nop 7" : "+v"(acc));
#pragma unroll
            for (int r = 0; r < 4; ++r) { const int t = 16 * I + 4 * fq + r, sx = 16 * J + fr; sm[O_B + t * ST + sx] = (sx <= t) ? acc[r] : 0.f; } }
        __syncthreads();
#pragma unroll
        for (int tt = 0; tt < 2; ++tt) { const int T = 2 * w + tt, ti = T >> 2, ei = T & 3; const int j = dir ? 63 - (16 * ti + fr) : 16 * ti + fr; const int ks = dir ? 4 * (4 - ti) : 4 * (ti + 1);
            f32x4 acc = {0.f, 0.f, 0.f, 0.f};
#pragma unroll 4
            for (int k0 = 0; k0 < 64; k0 += 4) acc = mm4(sm[O_QB + j * ST + k0 + fq], sm[O_S + (k0 + fq) * 64 + 16 * ei + fr], acc);
            for (int kk = 0; kk < ks; ++kk) acc = mm4(sm[O_B + j * ST + 4 * kk + fq], sm[O_V + (4 * kk + fq) * 64 + 16 * ei + fr], acc);
            asm volatile("s_nop 15\n\ts_nop 7" : "+v"(acc)); oacc[tt] += acc; }
        __syncthreads();
    }
#pragma unroll
    for (int tt = 0; tt < 2; ++tt) { const int T = 2 * w + tt, ti = T >> 2, ei = T & 3;
#pragma unroll
        for (int r = 0; r < 4; ++r) sm[O_Q + (16 * ti + 4 * fq + r) * ST + 16 * ei + fr] = oacc[tt][r]; }
    const int tl = tid >> 3, e0 = (tid & 7) * 8;
    const u32x4 hgw = *(const u32x4*)(HGs + (size_t)(tok0 + tl) * 256 + h * 64 + e0);
    const f32x4 n0 = *(const f32x4*)(normg + h * 64 + e0), n1 = *(const f32x4*)(normg + h * 64 + e0 + 4);
    __syncthreads();
    float ov[8]; float ss = 0.f;
#pragma unroll
    for (int e = 0; e < 8; ++e) { ov[e] = sm[O_Q + tl * ST + e0 + e]; ss += ov[e] * ov[e]; }
    ss = sum8(ss);
    const float rn = rsqrtf(ss * (1.f / 64.f) + 1e-6f);
    const size_t tok = (size_t)(tok0 + tl);
    float gv[8]; unpack8(hgw, gv);
    const float ng[8] = {n0[0], n0[1], n0[2], n0[3], n1[0], n1[1], n1[2], n1[3]};
#pragma unroll
    for (int e = 0; e < 8; ++e) ov[e] = ov[e] * rn * ng[e] * gv[e];
    st8_bf16(MIX + tok * 1024 + h * 64 + e0, ov);
    __syncthreads();
    }
}
}

namespace rg {
constexpr int XS = 65, XBS = 72;
constexpr int OB_XC = 0, OB_XB = 33280, OB_WT = 51712, OB_AGG = 88576;
struct PreR { f32x4 x[2][4][2]; };
__device__ __forceinline__ PreR issue_r(int u, const float* RX, int tid) {
    const int chunk = u & 127, n = (u >> 7) & 3, b = u >> 9; const int t0 = chunk * 128; PreR r;
#pragma unroll
    for (int i2 = 0; i2 < 2; ++i2) { const int it = tid + i2 * 512; const int tl = it >> 3, c8 = (it & 7) * 8; const int ch = n * 64 + c8;
#pragma unroll
        for (int jj = 0; jj < 4; ++jj) { const int t = t0 + tl - 2 + jj; const bool ok = (t >= 0 && t < SEQ);
            const float* xp = RX + ((size_t)b * SEQ + (ok ? t : 0)) * 256 + ch;
            const f32x4 x0 = *(const f32x4*)xp, x1 = *(const f32x4*)(xp + 4); const f32x4 zz = {0.f, 0.f, 0.f, 0.f};
            r.x[i2][jj][0] = ok ? x0 : zz; r.x[i2][jj][1] = ok ? x1 : zz; } }
    return r;
}
template <bool FULL>
__device__ __forceinline__ void unit(LAS unsigned char* smb, int u, const float* RX, const bf16_t* RYg, const float* cw, const float* cb, const bf16_t* RGW, const float* ba, const float* bx,
                                     const float* lamp, float* AGG, const float* CAR, bf16_t* MIX) {
    const int tid = ltid(), lane = tid & 63, w = tid >> 6, fr = lane & 15, fq = lane >> 4; const int chunk = u & 127, n = (u >> 7) & 3, b = u >> 9;
    const int t0 = chunk * 128;
    LAS float* sxc = (LAS float*)(smb + OB_XC); LAS float* sag = (LAS float*)(smb + OB_AGG);
    { const bf16_t* src = RGW + (size_t)n * 16384;
#pragma unroll
      for (int q = 0; q < 4; ++q) { const int cidx = tid + q * 512, row = cidx >> 3, c8 = (cidx & 7) * 8;
          *(LAS u32x4*)(smb + OB_WT + (row * XBS + c8) * 2) = *(const u32x4*)(src + (size_t)row * 64 + c8); } }
    for (int it = tid; it < 128 * 8; it += 512) { const int tl = it >> 3, c8 = (it & 7) * 8; const int ch = n * 64 + c8;
        float a[8];
        { const f32x4 b0 = *(const f32x4*)(cb + ch), b1 = *(const f32x4*)(cb + ch + 4); a[0] = b0[0]; a[1] = b0[1]; a[2] = b0[2]; a[3] = b0[3]; a[4] = b1[0]; a[5] = b1[1]; a[6] = b1[2]; a[7] = b1[3]; }
#pragma unroll
        for (int jj = 0; jj < 4; ++jj) { const int t = t0 + tl - 2 + jj; if (t < 0 || t >= SEQ) continue;
            const float* xp = RX + ((size_t)b * SEQ + t) * 256 + ch; const f32x4 x0 = *(const f32x4*)xp, x1 = *(const f32x4*)(xp + 4);
            const f32x4 w0 = *(const f32x4*)(cw + jj * 256 + ch), w1 = *(const f32x4*)(cw + jj * 256 + ch + 4);
            a[0] += w0[0] * x0[0]; a[1] += w0[1] * x0[1]; a[2] += w0[2] * x0[2]; a[3] += w0[3] * x0[3]; a[4] += w1[0] * x1[0]; a[5] += w1[1] * x1[1]; a[6] += w1[2] * x1[2]; a[7] += w1[3] * x1[3]; }
#pragma unroll
        for (int e = 0; e < 8; ++e) sxc[tl * XS + c8 + e] = a[e];
        *(LAS u32x4*)(smb + OB_XB + (tl * XBS + c8) * 2) = pack8(a); }
    __syncthreads();
    f32x4 acc[4][4];
    { const bf16x8 a0 = *(const LAS bf16x8*)(smb + OB_XB + ((16 * w + fr) * XBS + 8 * fq) * 2), a1 = *(const LAS bf16x8*)(smb + OB_XB + ((16 * w + fr) * XBS + 32 + 8 * fq) * 2);
#pragma unroll
      for (int g = 0; g < 4; ++g)
#pragma unroll
          for (int cg = 0; cg < 4; ++cg) { const int wb = OB_WT + ((g * 64 + 16 * cg + fr) * XBS + 8 * fq) * 2;
              const bf16x8 b0 = *(const LAS bf16x8*)(smb + wb), b1 = *(const LAS bf16x8*)(smb + wb + 64);
              f32x4 c = {0.f, 0.f, 0.f, 0.f}; c = __builtin_amdgcn_mfma_f32_16x16x32_bf16(a0, b0, c, 0, 0, 0); acc[g][cg] = __builtin_amdgcn_mfma_f32_16x16x32_bf16(a1, b1, c, 0, 0, 0); } }
    float av0[16], uv0[16], av1[16], uv1[16];
    const int run = 4 * w + fq;
#pragma unroll
    for (int cg = 0; cg < 4; ++cg) { const int ch = n * 64 + 16 * cg + fr;
        const float ba0 = ba[ch], ba1 = ba[256 + ch], bx0 = bx[ch], bx1 = bx[256 + ch];
        const float sp0 = log1pf(__expf(-lamp[ch])), sp1 = log1pf(__expf(-lamp[256 + ch]));
        float Af = 1.f, Bf = 0.f, Ab = 1.f, Bb = 0.f;
#pragma unroll
        for (int r = 0; r < 4; ++r) { const float xc = sxc[(16 * w + 4 * fq + r) * XS + 16 * cg + fr];
            { const float rr = sigm(acc[0][cg][r] + ba0), ig = sigm(acc[2][cg][r] + bx0); const float la = -8.f * rr * sp0; av0[cg * 4 + r] = __expf(la); uv0[cg * 4 + r] = __builtin_amdgcn_sqrtf(nexpm1(2.f * la)) * (ig * xc); }
            { const float rr = sigm(acc[1][cg][r] + ba1), ig = sigm(acc[3][cg][r] + bx1); const float la = -8.f * rr * sp1; av1[cg * 4 + r] = __expf(la); uv1[cg * 4 + r] = __builtin_amdgcn_sqrtf(nexpm1(2.f * la)) * (ig * xc); }
            Bf = av0[cg * 4 + r] * Bf + uv0[cg * 4 + r]; Af *= av0[cg * 4 + r]; Bb += Ab * uv1[cg * 4 + r]; Ab *= av1[cg * 4 + r]; }
        sag[((0 * 32 + run) * 64 + 16 * cg + fr) * 2] = Af; sag[((0 * 32 + run) * 64 + 16 * cg + fr) * 2 + 1] = Bf;
        sag[((1 * 32 + run) * 64 + 16 * cg + fr) * 2] = Ab; sag[((1 * 32 + run) * 64 + 16 * cg + fr) * 2 + 1] = Bb; }
    __syncthreads();
    if (tid < 128) { const int dir = tid >> 6, j = tid & 63, ch = n * 64 + j;
        if (!FULL) { float A = 1.f, Bv = 0.f;
            if (dir == 0) { for (int s = 0; s < 32; ++s) { const float a = sag[((0 * 32 + s) * 64 + j) * 2], bb = sag[((0 * 32 + s) * 64 + j) * 2 + 1]; Bv = a * Bv + bb; A *= a; } }
            else { for (int s = 31; s >= 0; --s) { const float a = sag[((1 * 32 + s) * 64 + j) * 2], bb = sag[((1 * 32 + s) * 64 + j) * 2 + 1]; Bv = a * Bv + bb; A *= a; } }
            float* ap = AGG + ((size_t)((b * 2 + dir) * 128 + chunk) * 256 + ch) * 2; ap[0] = A; ap[1] = Bv;
        } else { float hc = CAR[(size_t)((b * 2 + dir) * 128 + chunk) * 256 + ch];
            if (dir == 0) { for (int s = 0; s < 32; ++s) { const int ix = ((0 * 32 + s) * 64 + j) * 2; const float a = sag[ix], bb = sag[ix + 1]; sag[ix] = hc; hc = a * hc + bb; } }
            else { for (int s = 31; s >= 0; --s) { const int ix = ((1 * 32 + s) * 64 + j) * 2; const float a = sag[ix], bb = sag[ix + 1]; sag[ix] = hc; hc = a * hc + bb; } } } }
    if (FULL) {
        __syncthreads();
        const size_t tokb = (size_t)b * SEQ + t0 + 16 * w + 4 * fq;
#pragma unroll
        for (int cg = 0; cg < 4; ++cg) { const int ch = n * 64 + 16 * cg + fr;
            float hf = sag[((0 * 32 + run) * 64 + 16 * cg + fr) * 2], hb = sag[((1 * 32 + run) * 64 + 16 * cg + fr) * 2]; float hs[4];
#pragma unroll
            for (int r = 0; r < 4; ++r) { hf = av0[cg * 4 + r] * hf + uv0[cg * 4 + r]; hs[r] = hf; }
#pragma unroll
            for (int r = 3; r >= 0; --r) { hb = av1[cg * 4 + r] * hb + uv1[cg * 4 + r]; hs[r] += hb; }
#pragma unroll
            for (int r = 0; r < 4; ++r) { const float y = bf2f(RYg[(tokb + r) * 256 + ch]); MIX[(tokb + r) * 1024 + 256 + ch] = (bf16_t)f2bf(hs[r] * y); } }
    }
    __syncthreads();
}
template <bool FULL>
__device__ __forceinline__ void unit_pre(LAS unsigned char* smb, int u, const PreR& pre, int pre_tid, const bf16_t* RYg, const float* cw, const float* cb, const bf16_t* RGW, const float* ba, const float* bx,
                                     const float* lamp, float* AGG, const float* CAR, bf16_t* MIX) {
    const int tid = pre_tid, lane = tid & 63, w = __builtin_amdgcn_readfirstlane(tid >> 6), fr = lane & 15, fq = lane >> 4; const int chunk = u & 127, n = (u >> 7) & 3, b = u >> 9;
    const int t0 = chunk * 128;
    LAS float* sxc = (LAS float*)(smb + OB_XC); LAS float* sag = (LAS float*)(smb + OB_AGG);
    float gc[4][6];
#pragma unroll
    for (int cg = 0; cg < 4; ++cg) { const int ch = n * 64 + 16 * cg + fr; gc[cg][0] = ba[ch]; gc[cg][1] = ba[256 + ch]; gc[cg][2] = bx[ch]; gc[cg][3] = bx[256 + ch]; gc[cg][4] = lamp[ch]; gc[cg][5] = lamp[256 + ch]; }
    float car_pre = 0.f; if (FULL && tid < 128) car_pre = CAR[(size_t)((b * 2 + (tid >> 6)) * 128 + chunk) * 256 + n * 64 + (tid & 63)];
    { const bf16_t* src = RGW + (size_t)n * 16384;
#pragma unroll
      for (int q = 0; q < 4; ++q) { const int cidx = tid + q * 512, row = cidx >> 3, c8 = (cidx & 7) * 8;
          *(LAS u32x4*)(smb + OB_WT + (row * XBS + c8) * 2) = *(const u32x4*)(src + (size_t)row * 64 + c8); } }
#pragma unroll
    for (int i2 = 0; i2 < 2; ++i2) { const int it = tid + i2 * 512; const int tl = it >> 3, c8 = (it & 7) * 8; const int ch = n * 64 + c8;
        float a[8];
        { const f32x4 b0 = *(const f32x4*)(cb + ch), b1 = *(const f32x4*)(cb + ch + 4); a[0] = b0[0]; a[1] = b0[1]; a[2] = b0[2]; a[3] = b0[3]; a[4] = b1[0]; a[5] = b1[1]; a[6] = b1[2]; a[7] = b1[3]; }
#pragma unroll
        for (int jj = 0; jj < 4; ++jj) { const f32x4 x0 = pre.x[i2][jj][0], x1 = pre.x[i2][jj][1];
            const f32x4 w0 = *(const f32x4*)(cw + jj * 256 + ch), w1 = *(const f32x4*)(cw + jj * 256 + ch + 4);
            a[0] += w0[0] * x0[0]; a[1] += w0[1] * x0[1]; a[2] += w0[2] * x0[2]; a[3] += w0[3] * x0[3]; a[4] += w1[0] * x1[0]; a[5] += w1[1] * x1[1]; a[6] += w1[2] * x1[2]; a[7] += w1[3] * x1[3]; }
#pragma unroll
        for (int e = 0; e < 8; ++e) sxc[tl * XS + c8 + e] = a[e];
        *(LAS u32x4*)(smb + OB_XB + (tl * XBS + c8) * 2) = pack8(a); }
    __syncthreads();
    f32x4 acc[4][4];
    { const bf16x8 a0 = *(const LAS bf16x8*)(smb + OB_XB + ((16 * w + fr) * XBS + 8 * fq) * 2), a1 = *(const LAS bf16x8*)(smb + OB_XB + ((16 * w + fr) * XBS + 32 + 8 * fq) * 2);
#pragma unroll
      for (int g = 0; g < 4; ++g)
#pragma unroll
          for (int cg = 0; cg < 4; ++cg) { const int wb = OB_WT + ((g * 64 + 16 * cg + fr) * XBS + 8 * fq) * 2;
              const bf16x8 b0 = *(const LAS bf16x8*)(smb + wb), b1 = *(const LAS bf16x8*)(smb + wb + 64);
              f32x4 c = {0.f, 0.f, 0.f, 0.f}; c = __builtin_amdgcn_mfma_f32_16x16x32_bf16(a0, b0, c, 0, 0, 0); acc[g][cg] = __builtin_amdgcn_mfma_f32_16x16x32_bf16(a1, b1, c, 0, 0, 0); } }
    float av0[16], uv0[16], av1[16], uv1[16];
    const int run = 4 * w + fq;
    unsigned short ryv[16];
    if (FULL) { const size_t tokb_ = (size_t)b * SEQ + t0 + 16 * w + 4 * fq;
#pragma unroll
        for (int cg = 0; cg < 4; ++cg)
#pragma unroll
            for (int r = 0; r < 4; ++r) ryv[cg * 4 + r] = RYg[(tokb_ + r) * 256 + n * 64 + 16 * cg + fr]; }
#pragma unroll
    for (int cg = 0; cg < 4; ++cg) { const int ch = n * 64 + 16 * cg + fr;
        const float ba0 = gc[cg][0], ba1 = gc[cg][1], bx0 = gc[cg][2], bx1 = gc[cg][3];
        const float sp0 = log1pf(__expf(-gc[cg][4])), sp1 = log1pf(__expf(-gc[cg][5]));
        float Af = 1.f, Bf = 0.f, Ab = 1.f, Bb = 0.f;
#pragma unroll
        for (int r = 0; r < 4; ++r) { const float xc = sxc[(16 * w + 4 * fq + r) * XS + 16 * cg + fr];
            { const float rr = sigm(acc[0][cg][r] + ba0), ig = sigm(acc[2][cg][r] + bx0); const float la = -8.f * rr * sp0; av0[cg * 4 + r] = __expf(la); uv0[cg * 4 + r] = __builtin_amdgcn_sqrtf(nexpm1(2.f * la)) * (ig * xc); }
            { const float rr = sigm(acc[1][cg][r] + ba1), ig = sigm(acc[3][cg][r] + bx1); const float la = -8.f * rr * sp1; av1[cg * 4 + r] = __expf(la); uv1[cg * 4 + r] = __builtin_amdgcn_sqrtf(nexpm1(2.f * la)) * (ig * xc); }
            Bf = av0[cg * 4 + r] * Bf + uv0[cg * 4 + r]; Af *= av0[cg * 4 + r]; Bb += Ab * uv1[cg * 4 + r]; Ab *= av1[cg * 4 + r]; }
        sag[((0 * 32 + run) * 64 + 16 * cg + fr) * 2] = Af; sag[((0 * 32 + run) * 64 + 16 * cg + fr) * 2 + 1] = Bf;
        sag[((1 * 32 + run) * 64 + 16 * cg + fr) * 2] = Ab; sag[((1 * 32 + run) * 64 + 16 * cg + fr) * 2 + 1] = Bb; }
    __syncthreads();
    if (tid < 128) { const int dir = tid >> 6, j = tid & 63, ch = n * 64 + j;
        if (!FULL) { float A = 1.f, Bv = 0.f;
            if (dir == 0) { for (int s = 0; s < 32; ++s) { const float a = sag[((0 * 32 + s) * 64 + j) * 2], bb = sag[((0 * 32 + s) * 64 + j) * 2 + 1]; Bv = a * Bv + bb; A *= a; } }
            else { for (int s = 31; s >= 0; --s) { const float a = sag[((1 * 32 + s) * 64 + j) * 2], bb = sag[((1 * 32 + s) * 64 + j) * 2 + 1]; Bv = a * Bv + bb; A *= a; } }
            float* ap = AGG + ((size_t)((b * 2 + dir) * 128 + chunk) * 256 + ch) * 2; ap[0] = A; ap[1] = Bv;
        } else { float hc = car_pre;
            if (dir == 0) { for (int s = 0; s < 32; ++s) { const int ix = ((0 * 32 + s) * 64 + j) * 2; const float a = sag[ix], bb = sag[ix + 1]; sag[ix] = hc; hc = a * hc + bb; } }
            else { for (int s = 31; s >= 0; --s) { const int ix = ((1 * 32 + s) * 64 + j) * 2; const float a = sag[ix], bb = sag[ix + 1]; sag[ix] = hc; hc = a * hc + bb; } } } }
    if (FULL) {
        __syncthreads();
        const size_t tokb = (size_t)b * SEQ + t0 + 16 * w + 4 * fq;
#pragma unroll
        for (int cg = 0; cg < 4; ++cg) { const int ch = n * 64 + 16 * cg + fr;
            float hf = sag[((0 * 32 + run) * 64 + 16 * cg + fr) * 2], hb = sag[((1 * 32 + run) * 64 + 16 * cg + fr) * 2]; float hs[4];
#pragma unroll
            for (int r = 0; r < 4; ++r) { hf = av0[cg * 4 + r] * hf + uv0[cg * 4 + r]; hs[r] = hf; }
#pragma unroll
            for (int r = 3; r >= 0; --r) { hb = av1[cg * 4 + r] * hb + uv1[cg * 4 + r]; hs[r] += hb; }
#pragma unroll
            for (int r = 0; r < 4; ++r) { const float y = bf2f(ryv[cg * 4 + r]); MIX[(tokb + r) * 1024 + 256 + ch] = (bf16_t)f2bf(hs[r] * y); } }
    }
    __syncthreads();
}
template <bool FULL>
__device__ __forceinline__ void phase_rg(LAS unsigned char* smb, int blk, int G, const float* RX, const bf16_t* RYg, const float* cw, const float* cb, const bf16_t* RGW, const float* ba, const float* bx,
                                         const float* lamp, float* AGG, const float* CAR, bf16_t* MIX) {
    const int tid = ltid(); int u = blk; if (u >= 1024) return;
    PreR pre = issue_r(u, RX, tid);
#pragma unroll 1
    for (; u < 1024; u += G) { PreR nxt = pre; if (u + G < 1024) nxt = issue_r(u + G, RX, tid);
        unit_pre<FULL>(smb, u, pre, tid, RYg, cw, cb, RGW, ba, bx, lamp, AGG, CAR, MIX); pre = nxt; }
}
}

template <int MODE>
__device__ __forceinline__ void p0_transpose_item(const float* W, int K, int N, bf16_t* WT, LAS float* scr, int item, int lane) {
    const int nblk = N / 32, kb = item / nblk, nb = item % nblk, k0 = 64 * kb, n0 = 32 * nb;
#pragma unroll 16
    for (int i = 0; i < 32; ++i) { const int kk = 2 * i + (lane >> 5); scr[kk * 33 + (lane & 31)] = W[(size_t)(k0 + kk) * N + n0 + (lane & 31)]; }
    asm volatile("s_waitcnt lgkmcnt(0)" ::: "memory");
    const int c = lane & 7;
#pragma unroll
    for (int jx = 0; jx < 4; ++jx) { const int n = (lane >> 3) + 8 * jx; const LAS float* s = scr + (8 * c) * 33 + n;
        u32x4 o; o.x = pk2(s[0 * 33], s[1 * 33]); o.y = pk2(s[2 * 33], s[3 * 33]); o.z = pk2(s[4 * 33], s[5 * 33]); o.w = pk2(s[6 * 33], s[7 * 33]);
        int nr = n0 + n;
        if (MODE == 1) { if (nr >= 1792 && nr < 2816) { const int l = nr & 63; nr = (nr & ~63) + ((l & 31) << 1) + (l >> 5); } }
        if (MODE == 2) { if (nr < DFF) nr = ((nr >> 7) << 8) + (nr & 127); else { const int cc = nr - DFF; nr = ((cc >> 7) << 8) + 128 + (cc & 127); } }
        *(u32x4*)(WT + (size_t)nr * K + k0 + 8 * c) = o; }
    asm volatile("s_waitcnt lgkmcnt(0)" ::: "memory");
}

#define XB_TMO      128
#define XB_XCNT(j)  (256  + 64 * (j))
#define XB_XSUB(j)  (1280 + 64 * (j))
#define XB_XGEN(j)  (2304 + 64 * (j))
#define XB_TOP      3328
#define XB_TOPGEN   3392
#define XCD_BAR_WORDS 3456
#define XB_SPIN_CAP (1u << 18)

__device__ __forceinline__ unsigned xb_ld(unsigned* p)              { return __hip_atomic_load(p, __ATOMIC_RELAXED, __HIP_MEMORY_SCOPE_AGENT); }
__device__ __forceinline__ unsigned xb_add(unsigned* p, unsigned v) { return __hip_atomic_fetch_add(p, v, __ATOMIC_RELAXED, __HIP_MEMORY_SCOPE_AGENT); }
__device__ __forceinline__ unsigned xb_xcc_id() { return (unsigned)__builtin_amdgcn_s_getreg((3 << 11) | 20) & 0xFu; }
#define XB_SPIN(cond, bar) do { unsigned _sp = 0; while (cond) { __builtin_amdgcn_s_sleep(1); \
    if ((++_sp & 255u) == 0u) { if (xb_ld(&(bar)[XB_TMO])) break; if (_sp > XB_SPIN_CAP) { atomicAdd(&(bar)[XB_TMO], 1u); break; } } } } while (0)

struct XcdBarrier {
    unsigned* bar; unsigned x;
    volatile LAS unsigned* st;
};

__device__ __forceinline__ XcdBarrier xcd_barrier_post(unsigned* bar, volatile LAS unsigned* st) {
    XcdBarrier b; b.bar = bar; b.x = xb_xcc_id(); b.st = st;
    if (threadIdx.x == 0) (void)xb_add(&bar[XB_XCNT(b.x)], 1u);
    return b;
}
__device__ __forceinline__ void xcd_barrier_complete(unsigned* bar, unsigned x, unsigned& nloc, unsigned& nx) {
    const unsigned G = gridDim.x * gridDim.y * gridDim.z;
    unsigned sum, cnt, mine, sp = 0u;
    for (;;) {
        sum = 0u; cnt = 0u; mine = 0u;
#pragma unroll
        for (unsigned j = 0; j < 16; ++j) { const unsigned c = xb_ld(&bar[XB_XCNT(j)]); sum += c; cnt += (c > 0u) ? 1u : 0u; mine = (j == x) ? c : mine; }
        if (sum == G) break;
        __builtin_amdgcn_s_sleep(1);
        if ((++sp & 255u) == 0u) { if (xb_ld(&bar[XB_TMO])) break; if (sp > XB_SPIN_CAP) { atomicAdd(&bar[XB_TMO], 1u); break; } }
    }
    nloc = mine > 0u ? mine : 1u; nx = cnt > 0u ? cnt : 1u;
}

__device__ __forceinline__ void xcd_barrier(const XcdBarrier& b) {
    asm volatile("s_waitcnt vmcnt(0)" ::: "memory");
    __syncthreads();
    if (threadIdx.x == 0) {
        unsigned* bar = b.bar;
        __builtin_amdgcn_s_waitcnt(0);
        unsigned nloc = b.st[0], nx = b.st[1];
        if (nloc == 0u) { xcd_barrier_complete(bar, b.x, nloc, nx); b.st[0] = nloc; b.st[1] = nx; }
        const unsigned old = xb_add(&bar[XB_XSUB(b.x)], 1u);
        const unsigned gen = old / nloc;
        if (old + 1u == (gen + 1u) * nloc) {
            __builtin_amdgcn_fence(__ATOMIC_RELEASE, "agent");
            asm volatile("s_waitcnt vmcnt(0)" ::: "memory");
            const unsigned og = xb_add(&bar[XB_TOP], 1u);
            const unsigned tg = og / nx;
            if (og + 1u == (tg + 1u) * nx) xb_add(&bar[XB_TOPGEN], 1u);
            else XB_SPIN(xb_ld(&bar[XB_TOPGEN]) == tg, bar);
            __builtin_amdgcn_fence(__ATOMIC_ACQUIRE, "agent");
            xb_add(&bar[XB_XGEN(b.x)], 1u);
            asm volatile("s_waitcnt vmcnt(0)" ::: "memory");
        } else {
            XB_SPIN(xb_ld(&bar[XB_XGEN(b.x)]) == gen, bar);
            __builtin_amdgcn_fence(__ATOMIC_ACQUIRE, "agent");
            asm volatile("s_waitcnt vmcnt(0)" ::: "memory");
        }
    }
    __syncthreads();
}


#define GAS __attribute__((address_space(1)))
#define WSL() ({ GAS unsigned char* w_ = (GAS unsigned char*)p.ws; asm volatile("" : "+s"(w_)); (unsigned char*)w_; })
#define INP(k) ({ int k_ = (k); asm volatile("" : "+s"(k_)); (const float*)(const GAS float*)p.in[k_]; })
#define POUT() ((float*)(GAS float*)p.out)
#define LN_PASS(GI, BI, WRITE_X) do { IDS(); unsigned char* ws_ = WSL(); float* X_ = POUT(); bf16_t* XN_ = (bf16_t*)(ws_ + A_XN); float* ST_ = (float*)(ws_ + WS_STATS); const float* gg = INP(GI) + layer * DM; const float* bb = INP(BI) + layer * DM; \
        f32x4 gvv[4], bvv[4];   \
        _Pragma("unroll") for (int jx = 0; jx < 4; ++jx) { gvv[jx] = *(const f32x4*)(gg + jx * 256 + lane * 4); bvv[jx] = *(const f32x4*)(bb + jx * 256 + lane * 4); } \
        for (int m_ = bx * 16 + wave * 2; m_ < M; m_ += G * 16) {   \
            f32x4 v[2][4]; float s[2] = {0.f, 0.f}; \
            _Pragma("unroll") for (int q = 0; q < 2; ++q) _Pragma("unroll") for (int jx = 0; jx < 4; ++jx) v[q][jx] = *(const f32x4*)(X_ + (size_t)(m_ + q) * DM + jx * 256 + lane * 4); \
            _Pragma("unroll") for (int q = 0; q < 2; ++q) { const int m = m_ + q; float* xr = X_ + (size_t)m * DM; \
            _Pragma("unroll") for (int jx = 0; jx < 4; ++jx) s[q] += (v[q][jx][0] + v[q][jx][1]) + (v[q][jx][2] + v[q][jx][3]); \
            s[q] = sum64(s[q]); \
            const float mean = s[q] * (1.f / DM); float s2 = 0.f; \
            _Pragma("unroll") for (int jx = 0; jx < 4; ++jx) { v[q][jx] = v[q][jx] - mean; s2 += (v[q][jx][0] * v[q][jx][0] + v[q][jx][1] * v[q][jx][1]) + (v[q][jx][2] * v[q][jx][2] + v[q][jx][3] * v[q][jx][3]); } \
            s2 = sum64(s2); \
            const float rstd = rsqrtf(s2 * (1.f / DM) + 1e-5f); \
            if (lane == 0) { ST_[(size_t)m * 2] = mean; ST_[(size_t)m * 2 + 1] = rstd; } \
            _Pragma("unroll") for (int jx = 0; jx < 4; ++jx) { const f32x4 gv = gvv[jx], bv = bvv[jx]; \
                const f32x4 y = v[q][jx] * rstd * gv + bv; if (WRITE_X) *(f32x4*)(xr + jx * 256 + lane * 4) = y; \
                if (!(WRITE_X)) { u32x2 w; w.x = pk2(y[0], y[1]); w.y = pk2(y[2], y[3]); *(u32x2*)(XN_ + (size_t)m * DM + jx * 256 + lane * 4) = w; } } } } } while (0)

__global__ void __launch_bounds__(512, 2) fwd_megakernel(Params p) {
    extern __shared__ __attribute__((aligned(16))) unsigned char lds_raw[];
    cg::grid_group grid = cg::this_grid();
    LAS unsigned char* lds = (LAS unsigned char*)lds_raw;
    LAS float* smf = (LAS float*)lds_raw;
    volatile LAS unsigned* bst = (volatile LAS unsigned*)(lds + 131072 + 512);
    if (threadIdx.x < 2) bst[threadIdx.x] = 0u;
    __syncthreads();
    (void)xcd_barrier_post((unsigned*)((unsigned char*)(GAS unsigned char*)p.ws + WS_SMALL + 65536), bst);
#define GSYNC() do { XcdBarrier xb_; xb_.bar = (unsigned*)(WSL() + WS_SMALL + 65536); xb_.x = xb_xcc_id(); xb_.st = (volatile LAS unsigned*)(lds + 131072 + 512); xcd_barrier(xb_); } while (0)
#define IDS() const int tid = ltid(), lane = tid & 63, wave = tid >> 6, bx = lbid(), G = lgdim(); (void)lane; (void)wave; (void)bx; (void)G; (void)tid

    if (PH(0)) {
        IDS(); unsigned char* ws = WSL();
        const float* x_in = (const float*)(const GAS float*)p.in[0];
        bf16_t* XN = (bf16_t*)(ws + A_XN);
        float* COS = (float*)(ws + WS_COS); float* SIN = (float*)(ws + WS_SIN);
        float* LBT = (float*)(ws + WS_SMALL); float* LAMV = (float*)(ws + WS_SMALL + 8192);
        LAS float* scr = smf + wave * (64 * 33);
        const int gw = bx * 8 + wave, NGW = G * 8;
        constexpr int I_IN = 16 * (DIN / 32), I_SQ = 16 * 32, I_UP = 16 * (2 * DFF / 32), I_DN = (DFF / 64) * 32, I_L = I_IN + 4 * I_SQ + I_UP + I_DN;
        for (int it = gw; it < 2 * I_L; it += NGW) {
            const int l = it / I_L; int r = it % I_L; bf16_t* wl = (bf16_t*)(ws + WS_W + (size_t)l * W_LAYER);
            if (r < I_IN) { p0_transpose_item<1>((const float*)(const GAS float*)p.in[3] + (size_t)l * DM * DIN, DM, DIN, (bf16_t*)((char*)wl + W_IN), scr, r, lane); continue; } r -= I_IN;
            if (r < I_SQ) { p0_transpose_item<0>((const float*)(const GAS float*)p.in[15] + (size_t)l * DM * DM, DM, DM, (bf16_t*)((char*)wl + W_OUT), scr, r, lane); continue; } r -= I_SQ;
            if (r < I_SQ) { p0_transpose_item<0>((const float*)(const GAS float*)p.in[19] + (size_t)l * DM * DM, DM, DM, (bf16_t*)((char*)wl + W_K), scr, r, lane); continue; } r -= I_SQ;
            if (r < I_SQ) { p0_transpose_item<0>((const float*)(const GAS float*)p.in[20] + (size_t)l * DM * DM, DM, DM, (bf16_t*)((char*)wl + W_V), scr, r, lane); continue; } r -= I_SQ;
            if (r < I_SQ) { p0_transpose_item<0>((const float*)(const GAS float*)p.in[21] + (size_t)l * DM * DM, DM, DM, (bf16_t*)((char*)wl + W_O), scr, r, lane); continue; } r -= I_SQ;
            if (r < I_UP) { p0_transpose_item<2>((const float*)(const GAS float*)p.in[24] + (size_t)l * DM * 2 * DFF, DM, 2 * DFF, (bf16_t*)((char*)wl + W_UP), scr, r, lane); continue; } r -= I_UP;
            p0_transpose_item<0>((const float*)(const GAS float*)p.in[27] + (size_t)l * DFF * DM, DFF, DM, (bf16_t*)((char*)wl + W_DN), scr, r, lane);
        }
        const size_t gt = (size_t)bx * 512 + tid, NT = (size_t)G * 512;
        for (size_t i = gt; i < (size_t)M * DM / 8; i += 4 * NT) { f32x4 a[4], b[4];
#pragma unroll
            for (int q = 0; q < 4; ++q) { a[q] = *(const f32x4*)(x_in + (i + q * NT) * 8); b[q] = *(const f32x4*)(x_in + (i + q * NT) * 8 + 4); }
#pragma unroll
            for (int q = 0; q < 4; ++q) { u32x4 w; w.x = pk2(a[q][0], a[q][1]); w.y = pk2(a[q][2], a[q][3]); w.z = pk2(b[q][0], b[q][1]); w.w = pk2(b[q][2], b[q][3]); *(u32x4*)(XN + (i + q * NT) * 8) = w; } }
        { const float* mem = (const float*)(const GAS float*)p.in[1]; bf16_t* MEMB = (bf16_t*)(ws + A_MEMB);
          for (size_t i = gt; i < (size_t)BATCH * NMEM * DM / 8; i += NT) { const f32x4 a = *(const f32x4*)(mem + i * 8), b = *(const f32x4*)(mem + i * 8 + 4);
              u32x4 w; w.x = pk2(a[0], a[1]); w.y = pk2(a[2], a[3]); w.z = pk2(b[0], b[1]); w.w = pk2(b[2], b[3]); *(u32x4*)(MEMB + i * 8) = w; } }
        for (size_t i = gt; i < (size_t)2 * DM * DM / 8; i += NT) { const int l = (int)(i / (DM * DM / 8)); const size_t r = i % (DM * DM / 8);
            const float* src = (const float*)(const GAS float*)p.in[18] + (size_t)l * DM * DM + r * 8; bf16_t* dst = (bf16_t*)(ws + WS_W + (size_t)l * W_LAYER + W_Q) + r * 8;
            const f32x4 a = *(const f32x4*)src, b = *(const f32x4*)(src + 4);
            u32x4 w; w.x = pk2(a[0], a[1]); w.y = pk2(a[2], a[3]); w.z = pk2(b[0], b[1]); w.w = pk2(b[2], b[3]); *(u32x4*)dst = w; }
        { const int* pos = (const int*)(const GAS int*)p.in[2];
          for (size_t i = gt; i < (size_t)M * 32; i += NT) { const int tok = (int)(i >> 5), fi = (int)(i & 31);
              const double inv = exp(-(double)fi * (9.210340371976184 / 32.0)); const double ang = (double)pos[tok] * inv;
              const double k = rint(ang * 0.15915494309189535); double r = fma(-k, 6.283185307179586, ang); r = fma(-k, 2.4492935982947064e-16, r);
              const float rf = (float)r; COS[i] = cosf(rf); SIN[i] = sinf(rf); } }
        { bf16_t* RGW = (bf16_t*)(ws + WS_RGW); const float* wa = (const float*)(const GAS float*)p.in[8]; const float* wx = (const float*)(const GAS float*)p.in[10];
          for (size_t i = gt; i < (size_t)2 * 4 * 4 * 4096; i += NT) { const int ii = (int)(i & 63), jj = (int)((i >> 6) & 63), g = (int)((i >> 12) & 3), n = (int)((i >> 14) & 3), l = (int)(i >> 16);
              const float* src = (g < 2 ? wa : wx) + ((size_t)((l * 2 + (g & 1)) * 4 + n)) * 4096 + ii * 64 + jj; RGW[i] = (bf16_t)f2bf(*src); } }
        if (bx == 0) {
            const float* hlb = (const float*)(const GAS float*)p.in[4];
            for (int i = tid; i < 512; i += 512) { const float e0 = __expf(hlb[i]), e1 = __expf(hlb[512 + i]); LBT[i] = 0.f; LBT[512 + i] = e1 / (e0 + e1); }
            if (tid < 2) { const float* lp = (const float*)(const GAS float*)p.in[13] + tid * 256; float s1 = 0.f, s2 = 0.f; for (int k = 0; k < 64; ++k) { s1 += lp[k] * lp[64 + k]; s2 += lp[128 + k] * lp[192 + k]; }
                LAMV[tid] = expf(s1) - expf(s2) + (0.8f - 0.6f * expf(-0.3f * (float)tid)); }
        }
    }
    grid.sync();
    if (PH(1) && lbid() < 32) {
        IDS(); unsigned char* ws = WSL();
        const int ci = bx >> 3, l = ci >> 1, kv = ci & 1;
        pg8::Gemm g{(const bf16_t*)(ws + A_MEMB), (const bf16_t*)(ws + WS_W + (size_t)l * W_LAYER + (kv ? W_V : W_K)), 512, DM, DM, DM, DM, 1 << 30, 0};
        pg8::StaticOrder S; S.init(512, DM, 8, bx & 7);
        pg8::EpiRow8<FStore> E{{(bf16_t*)(ws + (kv ? A_VMEM : A_KMEM) + (size_t)l * MiB), DM}};
        pg8::gemm_phase(lds, g, S, E);
    }
    GSYNC();
    if (PH(2) && lbid() < 128) {
        IDS(); unsigned char* ws = WSL();
        const int ci = bx >> 2, which = ci >> 4, l = (ci >> 3) & 1, b = (ci >> 2) & 1, h = ci & 3;
        const bf16_t* wl = (const bf16_t*)(ws + WS_W + (size_t)l * W_LAYER);
        pg8::Gemm g; pg8::StaticOrder S; bf16_t* O;
        if (which == 0) {
            g = pg8::Gemm{(const bf16_t*)(ws + A_KMEM + (size_t)l * MiB) + (size_t)b * 256 * DM + h * 256, (const bf16_t*)((const char*)wl + W_Q) + h * 256, 256, DM, 256, DM, DM, 1 << 30, 0};
            S.init(256, DM, 4, bx & 3);
            O = (bf16_t*)(ws + WS_GB) + ((size_t)(l * 2 + b) * DM + h * 256) * DM;
        } else {
            g = pg8::Gemm{(const bf16_t*)((const char*)wl + W_O) + h * 256, (const bf16_t*)(ws + A_VMEM + (size_t)l * MiB) + (size_t)b * 256 * DM + h * 256, DM, 256, 256, DM, DM, 1 << 30, 0};
            S.init(DM, 256, 4, bx & 3);
            O = (bf16_t*)(ws + WS_BT2) + (size_t)(l * 2 + b) * DM * DM + h * 256;
        }
        pg8::EpiRow8<FStore> E{{O, DM}};
        pg8::gemm_phase(lds, g, S, E);
    }
    GSYNC();

#pragma unroll 1
    for (int layer = 0; layer < DEPTH; ++layer) {
        _Pragma("unroll 1") for (int rep_ = REPS(3); rep_ > 0; --rep_) if (PH(3)) {
            IDS(); unsigned char* ws = WSL();
            pg8::Gemm g{(const bf16_t*)(ws + A_XN), (const bf16_t*)(ws + WS_W + (size_t)layer * W_LAYER + W_IN), M, DIN, DM, DM, DM, 1 << 30, 0};
            pg8::StaticOrder S; S.init(M, DIN, G, bx);
            pg8::EpiRow8<FProj> E{{(bf16_t*)(ws + A_HQ), (bf16_t*)(ws + A_HI), (bf16_t*)(ws + A_HG), (bf16_t*)(ws + A_RY), (bf16_t*)(ws + A_DQ), (bf16_t*)(ws + A_DK), (bf16_t*)(ws + A_DV),
                                   (float*)(ws + A_ZF0), (float*)(ws + A_ZF1), (float*)(ws + A_RX), (const float*)(ws + WS_COS), (const float*)(ws + WS_SIN)}};
            pg8::gemm_phase(lds, g, S, E);
        }
        GSYNC();
        if (PH(4)) {
            IDS();
            { unsigned char* ws = WSL(); const float* lbt = (const float*)(ws + WS_SMALL) + layer * 512;
              _Pragma("unroll 1") for (int rep_ = REPS(4); rep_ > 0; --rep_) hg::phase_a(smf, bx, G, (const float*)(ws + A_ZF0), (const float*)(ws + A_ZF1), (const bf16_t*)(ws + A_HI), lbt, (float*)(ws + A_ST), (float*)(ws + A_HD)); }
            { unsigned char* ws = WSL();
              _Pragma("unroll 1") for (int rep_ = REPS(12); rep_ > 0; --rep_) rg::phase_rg<false>(lds, bx, G, (const float*)(ws + A_RX), (const bf16_t*)(ws + A_RY), INP(6) + layer * 1024, INP(7) + layer * 256, (const bf16_t*)(ws + WS_RGW) + (size_t)layer * 65536, INP(9) + layer * 512,
                                INP(11) + layer * 512, INP(12) + layer * 512, (float*)(ws + A_RGAGG), (const float*)(ws + A_RGCAR), (bf16_t*)(ws + A_XN)); }
        }
        GSYNC();
        { IDS(); unsigned char* ws = WSL();
          hg::phase_b((float*)(ws + A_ST), (const float*)(ws + A_HD));
          if (bx >= 128 && bx < 130) {
            const float* AGG = (const float*)(ws + A_RGAGG); float* CAR = (float*)(ws + A_RGCAR);
            const int gid = (bx - 128) * 512 + tid; const int ch = gid & 255, dir = (gid >> 8) & 1, b = gid >> 9;
            const size_t base = (size_t)((b * 2 + dir) * 128) * 256 + ch; float h = 0.f;
            typedef float f32x2 __attribute__((ext_vector_type(2)));
#pragma unroll 1
            for (int q0 = 0; q0 < 128; q0 += 16) { f32x2 ab[16];
#pragma unroll
                for (int i = 0; i < 16; ++i) { const int c = dir ? 127 - (q0 + i) : q0 + i; ab[i] = *(const f32x2*)(AGG + (base + (size_t)c * 256) * 2); }
#pragma unroll
                for (int i = 0; i < 16; ++i) { const int c = dir ? 127 - (q0 + i) : q0 + i; CAR[base + (size_t)c * 256] = h; h = ab[i][0] * h + ab[i][1]; } }
          } }
        GSYNC();
        if (PH(5)) {
            IDS();
            { unsigned char* ws = WSL(); const float* lbt = (const float*)(ws + WS_SMALL) + layer * 512;
              _Pragma("unroll 1") for (int rep_ = REPS(5); rep_ > 0; --rep_) hg::phase_c(smf, bx, G, (const float*)(ws + A_ZF0), (const float*)(ws + A_ZF1), (const bf16_t*)(ws + A_HQ), (const bf16_t*)(ws + A_HI), (const bf16_t*)(ws + A_HG), lbt,
                                                            (const float*)(ws + A_ST), INP(5) + layer * 256, (bf16_t*)(ws + A_XN)); }
            { unsigned char* ws = WSL();
              _Pragma("unroll 1") for (int rep_ = REPS(13); rep_ > 0; --rep_) rg::phase_rg<true>(lds, bx, G, (const float*)(ws + A_RX), (const bf16_t*)(ws + A_RY), INP(6) + layer * 1024, INP(7) + layer * 256, (const bf16_t*)(ws + WS_RGW) + (size_t)layer * 65536, INP(9) + layer * 512,
                               INP(11) + layer * 512, INP(12) + layer * 512, (float*)(ws + A_RGAGG), (const float*)(ws + A_RGCAR), (bf16_t*)(ws + A_XN)); }
        }
        _Pragma("unroll 1") for (int rep_ = REPS(6); rep_ > 0; --rep_) if (PH(6)) {
            IDS(); unsigned char* ws = WSL();
            const bf16_t* DQ = (const bf16_t*)(ws + A_DQ); const bf16_t* DK = (const bf16_t*)(ws + A_DK); const bf16_t* DV = (const bf16_t*)(ws + A_DV); bf16_t* MIX = (bf16_t*)(ws + A_XN);
            const float lam = ((const float*)(ws + WS_SMALL + 8192))[layer]; const float gscale = 1.f - (0.8f - 0.6f * expf(-0.3f * (float)layer));
            float* scratch = (float*)(ws + A_MIX_END) + (size_t)bx * 256 * 128;
            const float* subg = INP(14) + layer * 128;
            const int vcu = (G % 8 == 0) ? (bx % 8) * (G / 8) + bx / 8 : bx;
            for (int pr = vcu; pr < 512; pr += G) {
                const int bh = pr >> 6, qb = pr & 63, b = bh >> 2, h = bh & 3;
                const size_t row0 = (size_t)b * SEQ;
#pragma unroll 1
                for (int c = 0; c < 2; ++c) {
                    att::attn_unit(DQ + (row0 + qb * 256) * 512 + (h * 2 + c) * 64, DK + row0 * 512 + (h * 2 + c) * 64, DV + row0 * 512 + h * 128, SEQ, (char*)lds_raw,
                                   c, scratch, lam, gscale, subg, MIX + (row0 + qb * 256) * 1024 + 512 + h * 128);
                }
            }
        }
        GSYNC();
        if (PH(7)) {
            IDS(); unsigned char* ws = WSL();
            pg8::Gemm g{(const bf16_t*)(ws + A_XN), (const bf16_t*)(ws + WS_W + (size_t)layer * W_LAYER + W_OUT), M, DM, DM, DM, DM, 1 << 30, 0};
            pg8::StaticOrder S; S.init(M, DM, G, bx);
            EpiRes E{(layer == 0) ? (const float*)(const GAS float*)p.in[0] : (const float*)POUT(), POUT(), (layer == 0) ? (const float*)nullptr : (const float*)(ws + WS_STATS), INP(28) + (layer - 1) * DM, INP(29) + (layer - 1) * DM};
            pg8::gemm_phase(lds, g, S, E);
        }
        GSYNC();
        LN_PASS(16, 17, false);
        GSYNC();
        _Pragma("unroll 1") for (int rep_ = REPS(8); rep_ > 0; --rep_) if (PH(8)) {
            IDS(); unsigned char* ws = WSL();
            pg8::Gemm g{(const bf16_t*)(ws + A_XN), (const bf16_t*)(ws + WS_GB) + (size_t)layer * 2 * DM * DM, M, DM, DM, DM, DM, 64, (size_t)DM * DM};
            pg8::StaticOrder S; S.init(M, DM, G, bx);
            pg8::EpiRow8<FScores> E{{(bf16_t*)(ws + A_P), (float*)(ws + A_LSUM)}};
            pg8::gemm_phase(lds, g, S, E);
        }
        GSYNC();
        { IDS(); unsigned char* ws = WSL(); bf16_t* PB = (bf16_t*)(ws + A_P); const float* LS = (const float*)(ws + A_LSUM);
          const size_t NTH = (size_t)G * 512;
          for (size_t i0 = (size_t)bx * 512 + tid; i0 < (size_t)M * DM / 8; i0 += 2 * NTH) {
            f32x4 a[2], b[2]; u32x4 pw[2];
#pragma unroll
            for (int q = 0; q < 2; ++q) { const size_t i = i0 + q * NTH; const size_t row = i >> 7; const int c8 = (int)(i & 127) * 8, hd = c8 >> 8; const float* lp = LS + row * 32 + hd * 8;
                a[q] = *(const f32x4*)lp; b[q] = *(const f32x4*)(lp + 4); pw[q] = *(const u32x4*)(PB + i * 8); }
#pragma unroll
            for (int q = 0; q < 2; ++q) { const size_t i = i0 + q * NTH; const float inv = __builtin_amdgcn_rcpf(((a[q][0] + a[q][1]) + (a[q][2] + a[q][3])) + ((b[q][0] + b[q][1]) + (b[q][2] + b[q][3])));
                float v[8]; unpack8(pw[q], v);
#pragma unroll
                for (int e = 0; e < 8; ++e) v[e] *= inv;
                st8_bf16(PB + i * 8, v); }
          } }
        GSYNC();
        if (PH(9)) {
            IDS(); unsigned char* ws = WSL();
            pg8::Gemm g{(const bf16_t*)(ws + A_P), (const bf16_t*)(ws + WS_BT2) + (size_t)layer * 2 * DM * DM, M, DM, DM, DM, DM, 64, (size_t)DM * DM};
            pg8::StaticOrder S; S.init(M, DM, G, bx);
            EpiRes E{(const float*)POUT(), POUT(), (const float*)(ws + WS_STATS), INP(16) + layer * DM, INP(17) + layer * DM};
            pg8::gemm_phase(lds, g, S, E);
        }
        GSYNC();
        LN_PASS(22, 23, false);
        GSYNC();
        _Pragma("unroll 1") for (int rep_ = REPS(10); rep_ > 0; --rep_) if (PH(10)) {
            IDS(); unsigned char* ws = WSL();
            pg8::Gemm g{(const bf16_t*)(ws + A_XN), (const bf16_t*)(ws + WS_W + (size_t)layer * W_LAYER + W_UP), M, 2 * DFF, DM, DM, DM, 1 << 30, 0};
            pg8::StaticOrder S; S.init(M, 2 * DFF, G, bx);
            EpiUpConv E{(bf16_t*)(ws + A_VAL), (float*)(ws + A_GATE), INP(25) + (size_t)layer * 3 * DFF, INP(26) + (size_t)layer * DFF};
            pg8::gemm_phase<EpiUpConv, true>(lds, g, S, E);
        }
        GSYNC();
        {
            IDS(); unsigned char* ws = WSL(); bf16_t* H = (bf16_t*)(ws + A_VAL); const float* SB = (const float*)(ws + A_GATE);
            const float* cw = INP(25) + (size_t)layer * 3 * DFF;
            const size_t PL_ = 256 * (size_t)DFF;
            for (size_t i = (size_t)bx * 512 + tid; i < (size_t)2 * 256 * DFF; i += (size_t)G * 512) {
                const int side = (int)(i / (256 * (size_t)DFF)); const size_t r = i % (256 * (size_t)DFF); const int grp = (int)(r / DFF), c = (int)(r % DFF);
                float part, val, nb; size_t tok;
                if (side == 0) { part = SB[0 * PL_ + r]; val = SB[1 * PL_ + r]; nb = ((grp & 127) == 0) ? 0.f : SB[5 * PL_ + (size_t)(grp - 1) * DFF + c]; part += cw[c] * nb; tok = (size_t)grp * 128; }
                else { part = SB[3 * PL_ + r]; val = SB[4 * PL_ + r]; nb = ((grp & 127) == 127) ? 0.f : SB[2 * PL_ + (size_t)(grp + 1) * DFF + c]; part += cw[2 * DFF + c] * nb; tok = (size_t)grp * 128 + 127; }
                H[tok * DFF + c] = (bf16_t)f2bf(gelu_tanh(part) * val);
            }
        }
        GSYNC();
        if (PH(11)) {
            IDS(); unsigned char* ws = WSL();
            pg8::Gemm g{(const bf16_t*)(ws + A_VAL), (const bf16_t*)(ws + WS_W + (size_t)layer * W_LAYER + W_DN), M, DM, DFF, DFF, DFF, 1 << 30, 0};
            pg8::StaticOrder S; S.init(M, DM, G, bx);
            EpiRes E{(const float*)POUT(), POUT(), (const float*)(ws + WS_STATS), INP(22) + layer * DM, INP(23) + layer * DM};
            pg8::gemm_phase(lds, g, S, E);
        }
        GSYNC();
        LN_PASS(28, 29, (layer == DEPTH - 1));
        GSYNC();
    }
}

extern "C" void kernel_launch(void* const* d_in, const int* in_sizes, int n_in, void* d_out, int out_size, void* d_ws, size_t ws_size, hipStream_t stream) {
    static int grid_blocks = 0;
    if (grid_blocks == 0) {
        if (n_in != 30 || out_size != M * DM || ws_size < WS_END) { fprintf(stderr, "kernel_launch: unexpected shapes (n_in %d out %d ws %zu, need ws >= %zu)\n", n_in, out_size, ws_size, (size_t)WS_END); grid_blocks = -1; return; }
        int dev = 0, cus = 0, per_cu = 0;
        hipGetDevice(&dev); hipDeviceGetAttribute(&cus, hipDeviceAttributeMultiprocessorCount, dev);
        if (hipFuncSetAttribute((const void*)fwd_megakernel, hipFuncAttributeMaxDynamicSharedMemorySize, LDS_BYTES) != hipSuccess) { fprintf(stderr, "kernel_launch: hipFuncSetAttribute failed\n"); grid_blocks = -1; return; }
        hipOccupancyMaxActiveBlocksPerMultiprocessor(&per_cu, (const void*)fwd_megakernel, 512, LDS_BYTES);
        if (per_cu < 1) { fprintf(stderr, "kernel_launch: occupancy query says %d\n", per_cu); per_cu = 1; }
        grid_blocks = cus * 1;
        (void)hipGetLastError();
    }
    if (grid_blocks < 0) return;
    if (hipMemsetAsync((char*)d_ws + WS_SMALL + 65536, 0, 16384, stream) != hipSuccess) { fprintf(stderr, "kernel_launch: memset failed\n"); return; }
    Params p{};
    for (int i = 0; i < 30; ++i) p.in[i] = d_in[i];
    p.out = (float*)d_out; p.ws = (unsigned char*)d_ws;
    void* args[] = {&p};
    hipError_t e = hipLaunchCooperativeKernel((const void*)fwd_megakernel, dim3(grid_blocks), dim3(512), args, LDS_BYTES, stream);
    if (e != hipSuccess) fprintf(stderr, "cooperative launch failed: %s (grid %d)\n", hipGetErrorString(e), grid_blocks);
}
```
